# Optimizing an MI355X kernel written in HIP

```python
import math
import jax, jax.numpy as jnp
from jax import lax
import numpy as np


D_MODEL = 1024
BATCH = 4
SEQ = 4096
DEPTH = 4

HEAD_DIM = 64
ROPE_DIM = HEAD_DIM // 4
ROPE_THETA = 500000.0
Q_BLOCK = 128
FOX_HEADS = D_MODEL // (2 * HEAD_DIM)
NSA_HEADS = D_MODEL // (2 * HEAD_DIM)
NSA_KV_GROUPS = 2
NSA_HPG = NSA_HEADS // NSA_KV_GROUPS
CMP_BLOCK = 32
CMP_STRIDE = 16
CMP_HIDDEN = 2 * HEAD_DIM
SLC_BLOCK = 64
SLC_TOPK = 16
WINDOW = 512
DIFF_HEADS = D_MODEL // (2 * HEAD_DIM)
MEM_TOKENS = 256
MEM_HEADS = 4
D_FF = 256 * math.ceil(8 * D_MODEL / 3 / 256)
N_EVEN = (DEPTH + 1) // 2
N_ODD = DEPTH // 2
RMS_EPS = 1e-6

FOX_W = FOX_HEADS * HEAD_DIM
NSA_W = NSA_HEADS * HEAD_DIM
NSA_KV_W = NSA_KV_GROUPS * HEAD_DIM
EVEN_SPLITS = (FOX_W, FOX_W, FOX_W, FOX_HEADS, NSA_W) + (NSA_KV_W,) * 6 + (3 * NSA_HEADS,)
EVEN_IN = sum(EVEN_SPLITS)
MIX_W = FOX_W + NSA_W
DIFF_QK_W = DIFF_HEADS * 2 * HEAD_DIM
DIFF_V_W = DIFF_HEADS * 2 * HEAD_DIM
ODD_IN = 2 * DIFF_QK_W + DIFF_V_W
MEM_W = MEM_HEADS * HEAD_DIM

kernel_name = 'fox_nsa_diff_hybrid_trunk'


def rms_norm(x, g):
    xf = x.astype(jnp.float32)
    y = xf * lax.rsqrt(jnp.mean(xf * xf, axis=-1, keepdims=True) + RMS_EPS)
    return (y * g.astype(jnp.float32)).astype(x.dtype)


def rope_tables(positions):
    inv = ROPE_THETA ** (-jnp.arange(0, ROPE_DIM, 2, dtype=jnp.float32) / ROPE_DIM)
    ang = positions.astype(jnp.float32)[..., None] * inv
    return jnp.cos(ang), jnp.sin(ang)


def apply_partial_rope(x, cos, sin):
    half = ROPE_DIM // 2
    x1, x2, rest = x[..., :half], x[..., half:ROPE_DIM], x[..., ROPE_DIM:]
    c = cos[:, :, None, :].astype(x.dtype)
    s = sin[:, :, None, :].astype(x.dtype)
    return jnp.concatenate([x1 * c - x2 * s, x2 * c + x1 * s, rest], axis=-1)


def masked_softmax(logits, mask):
    z = jnp.where(mask, logits.astype(jnp.float32), -jnp.inf)
    m = jnp.max(z, axis=-1, keepdims=True)
    m = jnp.where(jnp.isfinite(m), m, 0.0)
    p = jnp.exp(z - m)
    return p / jnp.maximum(jnp.sum(p, axis=-1, keepdims=True), 1e-30)


def stack_blocks(out, B, T):
    return jnp.moveaxis(out, 0, 1).reshape((B, T) + out.shape[3:])


def fox_attention(q, k, v, log_f):
    B, T, H, dh = q.shape
    c = jnp.cumsum(log_f, axis=1)
    c_k = jnp.transpose(c, (0, 2, 1))[:, :, None, :]
    kpos = jnp.arange(T)
    scale = dh ** -0.5

    def block(i):
        q0 = i * Q_BLOCK
        qb = lax.dynamic_slice_in_dim(q, q0, Q_BLOCK, 1)
        cq = jnp.transpose(lax.dynamic_slice_in_dim(c, q0, Q_BLOCK, 1), (0, 2, 1))[..., None]
        s = jnp.einsum('bqhd,bkhd->bhqk', qb, k).astype(jnp.float32) * scale + (cq - c_k)
        qpos = q0 + jnp.arange(Q_BLOCK)
        p = masked_softmax(s, kpos[None, :] <= qpos[:, None])
        return jnp.einsum('bhqk,bkhd->bqhd', p.astype(v.dtype), v)

    return stack_blocks(lax.map(block, jnp.arange(T // Q_BLOCK)), B, T)


def compress(x, pos, w1, w2):
    B, T, G, dh = x.shape
    nc = (T - CMP_BLOCK) // CMP_STRIDE + 1
    idx = np.arange(nc)[:, None] * CMP_STRIDE + np.arange(CMP_BLOCK)[None, :]
    blocks = x[:, idx] + pos[None, None, :, None, :].astype(x.dtype)
    flat = jnp.moveaxis(blocks, 3, 2).reshape(B, nc, G, CMP_BLOCK * dh)
    return jax.nn.gelu(flat @ w1) @ w2


def nsa_attention(q, kc, vc, ks, vs, kw, vw, gates):
    B, T, H, dh = q.shape
    G = NSA_KV_GROUPS
    nc = kc.shape[1]
    ns = T // SLC_BLOCK
    n_sel = min(SLC_TOPK, ns)
    scale = dh ** -0.5
    cmp_start = np.arange(nc) * CMP_STRIDE
    slc_start = np.arange(ns) * SLC_BLOCK
    cmp_end = jnp.asarray(cmp_start + CMP_BLOCK - 1)
    ov = np.clip(np.minimum(cmp_start[:, None] + CMP_BLOCK, slc_start[None, :] + SLC_BLOCK)
                 - np.maximum(cmp_start[:, None], slc_start[None, :]), 0, None) / CMP_BLOCK
    overlap = jnp.asarray(ov, dtype=jnp.float32)
    blk = jnp.arange(ns)
    k_blocks = jnp.transpose(ks.reshape(B, ns, SLC_BLOCK, G, dh), (0, 3, 1, 2, 4))
    v_blocks = jnp.transpose(vs.reshape(B, ns, SLC_BLOCK, G, dh), (0, 3, 1, 2, 4))
    kw_pad = jnp.pad(kw, ((0, 0), (WINDOW, 0), (0, 0), (0, 0)))
    vw_pad = jnp.pad(vw, ((0, 0), (WINDOW, 0), (0, 0), (0, 0)))
    bi = jnp.arange(B)[:, None, None, None]
    gi = jnp.arange(G)[None, :, None, None]

    def block(i):
        q0 = i * Q_BLOCK
        qpos = q0 + jnp.arange(Q_BLOCK)
        qg = lax.dynamic_slice_in_dim(q, q0, Q_BLOCK, 1).reshape(B, Q_BLOCK, G, NSA_HPG, dh)
        gb = lax.dynamic_slice_in_dim(gates, q0, Q_BLOCK, 1).reshape(B, Q_BLOCK, G, NSA_HPG, 3)
        s_c = jnp.einsum('bqgnd,bcgd->bgnqc', qg, kc).astype(jnp.float32) * scale
        p_c = masked_softmax(s_c, cmp_end[None, :] <= qpos[:, None])
        o_c = jnp.einsum('bgnqc,bcgd->bqgnd', p_c.astype(vc.dtype), vc)
        imp = jnp.einsum('bgnqc,cs->bgqs', p_c, overlap)
        cur = (qpos // SLC_BLOCK)[:, None]
        valid = blk[None, :] * SLC_BLOCK <= qpos[:, None]
        forced = (blk[None, :] == 0) | (blk[None, :] == cur) | (blk[None, :] == cur - 1)
        score = jnp.where(valid, jnp.where(forced, jnp.inf, imp), -jnp.inf)
        _, sel = lax.top_k(score, n_sel)
        k_sel = k_blocks[bi, gi, sel]
        v_sel = v_blocks[bi, gi, sel].reshape(B, G, Q_BLOCK, n_sel * SLC_BLOCK, dh)
        tok = sel[..., None] * SLC_BLOCK + jnp.arange(SLC_BLOCK)
        smask = (tok <= qpos[None, None, :, None, None]).reshape(B, G, 1, Q_BLOCK, n_sel * SLC_BLOCK)
        s_s = jnp.einsum('bqgnd,bgqkld->bgnqkl', qg, k_sel).astype(jnp.float32) * scale
        p_s = masked_softmax(s_s.reshape(B, G, NSA_HPG, Q_BLOCK, n_sel * SLC_BLOCK), smask)
        o_s = jnp.einsum('bgnqm,bgqmd->bqgnd', p_s.astype(v_sel.dtype), v_sel)
        kwb = lax.dynamic_slice_in_dim(kw_pad, q0, WINDOW + Q_BLOCK, 1)
        vwb = lax.dynamic_slice_in_dim(vw_pad, q0, WINDOW + Q_BLOCK, 1)
        kpos = q0 - WINDOW + jnp.arange(WINDOW + Q_BLOCK)
        wmask = ((kpos[None, :] <= qpos[:, None]) & (kpos[None, :] > qpos[:, None] - WINDOW)
                 & (kpos[None, :] >= 0))
        s_w = jnp.einsum('bqgnd,bkgd->bgnqk', qg, kwb).astype(jnp.float32) * scale
        p_w = masked_softmax(s_w, wmask)
        o_w = jnp.einsum('bgnqk,bkgd->bqgnd', p_w.astype(vwb.dtype), vwb)
        o = gb[..., 0:1] * o_c + gb[..., 1:2] * o_s + gb[..., 2:3] * o_w
        return o.reshape(B, Q_BLOCK, H, dh)

    return stack_blocks(lax.map(block, jnp.arange(T // Q_BLOCK)), B, T)


def diff_attention(q1, q2, k1, k2, v, lam):
    B, T, H, dh = q1.shape
    kpos = jnp.arange(T)
    scale = dh ** -0.5

    def block(i):
        q0 = i * Q_BLOCK
        qpos = q0 + jnp.arange(Q_BLOCK)
        mask = kpos[None, :] <= qpos[:, None]
        qb1 = lax.dynamic_slice_in_dim(q1, q0, Q_BLOCK, 1)
        qb2 = lax.dynamic_slice_in_dim(q2, q0, Q_BLOCK, 1)
        a1 = masked_softmax(jnp.einsum('bqhd,bkhd->bhqk', qb1, k1).astype(jnp.float32) * scale, mask)
        a2 = masked_softmax(jnp.einsum('bqhd,bkhd->bhqk', qb2, k2).astype(jnp.float32) * scale, mask)
        p = a1 - lam * a2
        return jnp.einsum('bhqk,bkhd->bqhd', p.astype(v.dtype), v)

    return stack_blocks(lax.map(block, jnp.arange(T // Q_BLOCK)), B, T)


def even_mixer(h, cos, sin, w_in, f_bias, cpk, c1k, c2k, cpv, c1v, c2v, w_out):
    B, T, _ = h.shape
    G = NSA_KV_GROUPS
    offsets = [int(o) for o in np.cumsum(EVEN_SPLITS)[:-1]]
    fq, fk, fv, fl, nq, kc, vc, ksl, vsl, kwn, vwn, gl = jnp.split(h @ w_in, offsets, axis=-1)
    heads = lambda t, n: t.reshape(B, T, n, HEAD_DIM)
    rope = lambda t: apply_partial_rope(t, cos, sin)
    log_f = jax.nn.log_sigmoid(fl.astype(jnp.float32) + f_bias.astype(jnp.float32))
    o_fox = fox_attention(heads(fq, FOX_HEADS), heads(fk, FOX_HEADS), heads(fv, FOX_HEADS), log_f)
    o_nsa = nsa_attention(
        rope(heads(nq, NSA_HEADS)),
        compress(rope(heads(kc, G)), cpk, c1k, c2k),
        compress(heads(vc, G), cpv, c1v, c2v),
        rope(heads(ksl, G)), heads(vsl, G),
        rope(heads(kwn, G)), heads(vwn, G),
        jax.nn.sigmoid(gl).reshape(B, T, NSA_HEADS, 3))
    o = jnp.concatenate([o_fox.reshape(B, T, FOX_W), o_nsa.reshape(B, T, NSA_W)], axis=-1)
    return o @ w_out


def diff_mixer(h, cos, sin, w_in, lam_p, subln_g, w_out, layer):
    B, T, _ = h.shape
    q, k, v = jnp.split(h @ w_in, [DIFF_QK_W, 2 * DIFF_QK_W], axis=-1)
    q = apply_partial_rope(q.reshape(B, T, 2 * DIFF_HEADS, HEAD_DIM), cos, sin).reshape(B, T, DIFF_HEADS, 2, HEAD_DIM)
    k = apply_partial_rope(k.reshape(B, T, 2 * DIFF_HEADS, HEAD_DIM), cos, sin).reshape(B, T, DIFF_HEADS, 2, HEAD_DIM)
    v = v.reshape(B, T, DIFF_HEADS, 2 * HEAD_DIM)
    lam_init = 0.8 - 0.6 * math.exp(-0.3 * layer)
    lp = lam_p.astype(jnp.float32)
    lam = jnp.exp(jnp.sum(lp[0] * lp[1])) - jnp.exp(jnp.sum(lp[2] * lp[3])) + lam_init
    o = diff_attention(q[..., 0, :], q[..., 1, :], k[..., 0, :], k[..., 1, :], v, lam)
    o = rms_norm(o, subln_g) * (1.0 - lam_init)
    return o.reshape(B, T, DIFF_V_W) @ w_out


def memory_cross_attention(h, mem_n, wq, wk, wv, wo):
    B, T, _ = h.shape
    M = mem_n.shape[1]
    q = (h @ wq).reshape(B, T, MEM_HEADS, HEAD_DIM)
    k = (mem_n @ wk).reshape(B, M, MEM_HEADS, HEAD_DIM)
    v = (mem_n @ wv).reshape(B, M, MEM_HEADS, HEAD_DIM)
    s = jnp.einsum('bqhd,bmhd->bhqm', q, k).astype(jnp.float32) * HEAD_DIM ** -0.5
    p = jax.nn.softmax(s, axis=-1)
    o = jnp.einsum('bhqm,bmhd->bqhd', p.astype(v.dtype), v).reshape(B, T, MEM_W)
    return o @ wo


def swiglu(h, wg, wu, wd):
    return (jax.nn.silu(h @ wg) * (h @ wu)) @ wd


def setup_inputs(seed: int = 0) -> dict:
    key = jax.random.key(seed)
    ks = jax.random.split(key, 32)

    def nrm(k, shape, fan_in):
        return jax.random.normal(k, shape, jnp.float32) * (fan_in ** -0.5)

    def gain(k, shape):
        return 1.0 + 0.02 * jax.random.normal(k, shape, jnp.float32)

    D = D_MODEL
    flat_cmp = CMP_BLOCK * HEAD_DIM
    return {
        'x': jax.random.normal(ks[0], (BATCH, SEQ, D), jnp.float32),
        'mem': jax.random.normal(ks[1], (BATCH, MEM_TOKENS, D), jnp.float32),
        'positions': jnp.broadcast_to(jnp.arange(SEQ, dtype=jnp.int32), (BATCH, SEQ)),
        'sandwich_g': gain(ks[2], (DEPTH, 6, D)),
        'mem_norm_g': gain(ks[3], (DEPTH, D)),
        'ev_w_in': nrm(ks[4], (N_EVEN, D, EVEN_IN), D),
        'ev_fox_fbias': 4.0 + 0.5 * jax.random.normal(ks[5], (N_EVEN, FOX_HEADS), jnp.float32),
        'ev_cmp_pos_k': 0.02 * jax.random.normal(ks[6], (N_EVEN, CMP_BLOCK, HEAD_DIM), jnp.float32),
        'ev_cmp_w1_k': nrm(ks[7], (N_EVEN, flat_cmp, CMP_HIDDEN), flat_cmp),
        'ev_cmp_w2_k': nrm(ks[8], (N_EVEN, CMP_HIDDEN, HEAD_DIM), CMP_HIDDEN),
        'ev_cmp_pos_v': 0.02 * jax.random.normal(ks[9], (N_EVEN, CMP_BLOCK, HEAD_DIM), jnp.float32),
        'ev_cmp_w1_v': nrm(ks[10], (N_EVEN, flat_cmp, CMP_HIDDEN), flat_cmp),
        'ev_cmp_w2_v': nrm(ks[11], (N_EVEN, CMP_HIDDEN, HEAD_DIM), CMP_HIDDEN),
        'ev_w_out': nrm(ks[12], (N_EVEN, MIX_W, D), MIX_W),
        'od_w_in': nrm(ks[13], (N_ODD, D, ODD_IN), D),
        'od_lambda': 0.1 * jax.random.normal(ks[14], (N_ODD, 4, HEAD_DIM), jnp.float32),
        'od_subln_g': gain(ks[15], (N_ODD, 2 * HEAD_DIM)),
        'od_w_out': nrm(ks[16], (N_ODD, DIFF_V_W, D), DIFF_V_W),
        'ca_wq': nrm(ks[17], (DEPTH, D, MEM_W), D),
        'ca_wk': nrm(ks[18], (DEPTH, D, MEM_W), D),
        'ca_wv': nrm(ks[19], (DEPTH, D, MEM_W), D),
        'ca_wo': nrm(ks[20], (DEPTH, MEM_W, D), MEM_W),
        'ffn_wg': nrm(ks[21], (DEPTH, D, D_FF), D),
        'ffn_wu': nrm(ks[22], (DEPTH, D, D_FF), D),
        'ffn_wd': nrm(ks[23], (DEPTH, D_FF, D), D_FF),
    }


def reference(x, mem, positions, sandwich_g, mem_norm_g, ev_w_in, ev_fox_fbias,
              ev_cmp_pos_k, ev_cmp_w1_k, ev_cmp_w2_k, ev_cmp_pos_v, ev_cmp_w1_v, ev_cmp_w2_v,
              ev_w_out, od_w_in, od_lambda, od_subln_g, od_w_out,
              ca_wq, ca_wk, ca_wv, ca_wo, ffn_wg, ffn_wu, ffn_wd):
    cos, sin = rope_tables(positions)
    for layer in range(DEPTH):
        g = sandwich_g[layer]
        h = rms_norm(x, g[0])
        if layer % 2 == 0:
            e = layer // 2
            y = even_mixer(h, cos, sin, ev_w_in[e], ev_fox_fbias[e],
                           ev_cmp_pos_k[e], ev_cmp_w1_k[e], ev_cmp_w2_k[e],
                           ev_cmp_pos_v[e], ev_cmp_w1_v[e], ev_cmp_w2_v[e], ev_w_out[e])
        else:
            o = layer // 2
            y = diff_mixer(h, cos, sin, od_w_in[o], od_lambda[o], od_subln_g[o], od_w_out[o], layer)
        x = x + rms_norm(y, g[1])
        mem_n = rms_norm(mem, mem_norm_g[layer])
        y = memory_cross_attention(rms_norm(x, g[2]), mem_n, ca_wq[layer], ca_wk[layer], ca_wv[layer], ca_wo[layer])
        x = x + rms_norm(y, g[3])
        y = swiglu(rms_norm(x, g[4]), ffn_wg[layer], ffn_wu[layer], ffn_wd[layer])
        x = x + rms_norm(y, g[5])
    return x
```

```cpp
#include <hip/hip_runtime.h>
#include <hip/hip_bf16.h>
#include <cstdio>
#include <cstdint>
#include <cmath>

#ifndef MK_PER_PHASE
#define MK_PER_PHASE 0
#endif
#ifndef MK_STOP_PHASE
#define MK_STOP_PHASE 100000
#endif

constexpr int NB = 4, SEQ = 4096, DM = 1024, MTOK = NB * SEQ, DEPTH = 4;
constexpr int FFD = 2816, MEMT = 256;
constexpr int EVEN_IN = 2848, ODD_IN = 3072;
constexpr float LOG2E = 1.4426950408889634f;
constexpr float QSCALE = 0.125f * 1.4426950408889634f;
constexpr float RMS_EPS = 1e-6f;

constexpr size_t MiB = 1u << 20;
constexpr size_t WS_CTL = 0, CTL_ZERO_BYTES = 1 * MiB;
constexpr size_t WS_WB = 1 * MiB;
constexpr size_t WB_IN = 0, WB_OUT = 6 * MiB, WB_CMP = 8 * MiB, WB_CQKV = 9 * MiB, WB_CO = 10 * MiB + 512 * 1024, WB_GU = 11 * MiB, WB_D = 22 * MiB;
constexpr size_t WS_XN = 29 * MiB;
constexpr size_t WS_RA = 63 * MiB;
constexpr size_t WS_RB = 159 * MiB;
constexpr size_t WS_RS = 223 * MiB;
constexpr size_t WS_END = 247 * MiB;
constexpr size_t RA_QF = 0, RA_KF = 16 * MiB, RA_VF = 32 * MiB, RA_NQ = 48 * MiB, RA_KCR = 64 * MiB, RA_VCR = 68 * MiB, RA_KS = 72 * MiB, RA_VS = 76 * MiB, RA_KW = 80 * MiB, RA_VW = 84 * MiB;
constexpr size_t RA_Q = 0, RA_K = 32 * MiB, RA_V = 64 * MiB;
constexpr size_t RB_O = 0, RB_OC = 32 * MiB, RB_O2 = 32 * MiB, RB_CQ = 0, RB_CO = 8 * MiB;
constexpr size_t RS_COS = 0, RS_SIN = 512 * 1024, RS_FL = 1 * MiB, RS_GATE = 1 * MiB + 512 * 1024, RS_CB = 3 * MiB, RS_U = 4 * MiB, RS_KCMP = 12 * MiB, RS_VCMP = 12 * MiB + 256 * 1024,
                 RS_SELM = 12 * MiB + 512 * 1024, RS_MEMKV = 13 * MiB, RS_BIAS1 = 14 * MiB;

__device__ __forceinline__ int opaque_tid() { int t = threadIdx.x; asm volatile("" : "+v"(t)); return t; }

namespace pg8 {
#define PG8_LAS __attribute__((address_space(3)))
typedef unsigned short bf16_t;
typedef short bf16x8 __attribute__((ext_vector_type(8)));
typedef float f32x4 __attribute__((ext_vector_type(4)));
typedef unsigned u32x4 __attribute__((ext_vector_type(4)));
constexpr int BM = 256, BK = 64, HALF = 128, HTB = HALF * BK * 2  , STAGE_BYTES = 8 * HTB, NXCD = 8, WGM = 8;

__host__ __device__ __forceinline__ int lds_byte(int r, int c) { const int st = (r >> 4) * 2 + (c >> 5), rr = r & 15, cc = c & 31, ob = rr * 64 + cc * 2; return st * 1024 + (ob ^ (((ob >> 9) & 1) << 5)); }
__host__ __device__ __forceinline__ void stage_rc(int b, int& R, int& C) { const int st = b / 1024, sb = b % 1024, swz = sb ^ (((sb >> 9) & 1) << 5); R = (st >> 1) * 16 + swz / 64; C = (st & 1) * 32 + (swz % 64) / 2; }
__host__ __device__ __forceinline__ int perm32(int rho) { const int n = rho >> 4, i = rho & 15; return 8 * (i >> 2) + 4 * n + (i & 3); }

struct Unit { int pm, pn; };
struct Gemm { const bf16_t* A; const bf16_t* Bt; int M, N, K; };

struct StaticOrder {
    int nM, nN, nwg, G, c;
    __host__ __device__ void init(int M, int N, int G_, int c_) { nM = M / BM; nN = N / BM; nwg = nM * nN; G = G_; c = c_; }
    __host__ __device__ bool next(int i, Unit& u) const {
        const long L = (long)i * G + c; if (L >= nwg) return false;
        int wgid = (int)L; { const int q = nwg / NXCD, r = nwg % NXCD, xcd = wgid % NXCD, off = wgid / NXCD; wgid = (xcd < r ? xcd * (q + 1) : r * (q + 1) + (xcd - r) * q) + off; }
        const int nig = WGM * nN, gid = wgid / nig, fm = gid * WGM, gsz = (nM - fm) < WGM ? (nM - fm) : WGM;
        u.pm = fm + ((wgid % nig) % gsz); u.pn = (wgid % nig) / gsz; return true;
    }
    __device__ __forceinline__ void a_ready(const Unit&) const {}
    __device__ __forceinline__ void done(const Unit&) const {}
};

__device__ __forceinline__ unsigned cvt_pk_bf16(float lo, float hi) { unsigned r; asm volatile("v_cvt_pk_bf16_f32 %0, %1, %2" : "=v"(r) : "v"(lo), "v"(hi)); return r; }
typedef float f32x2 __attribute__((ext_vector_type(2)));
__device__ __forceinline__ u32x4 pack8(const f32x4 a, const f32x4 b) { u32x4 w; w.x = cvt_pk_bf16(a[0], a[1]); w.y = cvt_pk_bf16(a[2], a[3]); w.z = cvt_pk_bf16(b[0], b[1]); w.w = cvt_pk_bf16(b[2], b[3]); return w; }

struct EpiF32 {
    static constexpr bool PERM = false, AFTER_DRAIN = false;
    float* O; int ldc;
    __device__ __forceinline__ void operator()(const f32x4 (&acc)[2][2][4][2], const Unit& u, int wr, int wc, int fr, int fq) const {
        const int row0 = u.pm * BM + wr * 64 + fr, col0 = u.pn * BM + wc * 32 + 4 * fq;
#pragma unroll
        for (int ai = 0; ai < 2; ++ai)
#pragma unroll
            for (int m = 0; m < 4; ++m) { float* rowp = O + (size_t)(row0 + ai * HALF + m * 16) * ldc + col0;
#pragma unroll
                for (int bj = 0; bj < 2; ++bj)
#pragma unroll
                    for (int n = 0; n < 2; ++n) *(f32x4*)(rowp + bj * HALF + n * 16) = acc[ai][bj][m][n]; }
    }
};

__device__ __forceinline__ void rope8(f32x4& v0, f32x4& v1, const float* cs, const float* sn, int fq) {
    f32x4 p0, p1;
#pragma unroll
    for (int i = 0; i < 4; ++i) { p0[i] = __shfl_xor(v0[i], 16); p1[i] = __shfl_xor(v1[i], 16); }
    if (fq < 2) {
        const f32x4 cA = *(const f32x4*)cs, cB = *(const f32x4*)(cs + 4), sA = *(const f32x4*)sn, sB = *(const f32x4*)(sn + 4);
        const float sg = (fq == 0) ? -1.f : 1.f;
        v0 = v0 * cA + (p0 * sA) * sg; v1 = v1 * cB + (p1 * sB) * sg;
    }
}

struct EpiEvenIn {
    static constexpr bool PERM = true, AFTER_DRAIN = false;
    unsigned char* ws;
    __device__ __forceinline__ void operator()(const f32x4 (&acc)[2][2][4][2], const Unit& u, int wr, int wc, int fr, int fq) const {
        const int pn = u.pn, row0 = u.pm * BM + wr * 64 + fr;
        const bool ropewave = ((wc & 1) == 0);
        unsigned char* const ra = ws + WS_RA;
        const float* const COS = (const float*)(ws + WS_RS + RS_COS); const float* const SIN = (const float*)(ws + WS_RS + RS_SIN);
        float* const FL = (float*)(ws + WS_RS + RS_FL); float* const GATE = (float*)(ws + WS_RS + RS_GATE);
#pragma unroll
        for (int ai = 0; ai < 2; ++ai)
#pragma unroll
            for (int m = 0; m < 4; ++m) {
                const int row = row0 + ai * HALF + m * 16;
                const float* cs = COS + (size_t)row * 8; const float* sn = SIN + (size_t)row * 8;
#pragma unroll
                for (int bj = 0; bj < 2; ++bj) {
                    f32x4 v0 = acc[ai][bj][m][0], v1 = acc[ai][bj][m][1];
                    const int tc = bj * HALF + wc * 32 + 8 * fq;
                    if (pn < 8) {
                        bf16_t* base = (bf16_t*)(ra + (size_t)(pn >> 1) * (16 * MiB));
                        if (pn >= 6 && ropewave) rope8(v0, v1, cs, sn, fq);
                        if (pn < 2 || pn >= 6) { v0 = v0 * QSCALE; v1 = v1 * QSCALE; }
                        *(u32x4*)(base + (size_t)row * 512 + (pn & 1) * 256 + tc) = pack8(v0, v1);
                    } else if (pn == 8) {
                        if (bj == 0 && ropewave) rope8(v0, v1, cs, sn, fq);
                        bf16_t* base = (bf16_t*)(ra + (bj == 0 ? RA_KCR : RA_VCR));
                        const int c128 = wc * 32 + 8 * fq, g = c128 >> 6, d = c128 & 63, b = row >> 12, t = row & 4095;
                        *(u32x4*)(base + ((size_t)((b * 2 + g) * SEQ + t)) * 64 + d) = pack8(v0, v1);
                    } else if (pn == 9 || pn == 10) {
                        if (bj == 0 && ropewave) rope8(v0, v1, cs, sn, fq);
                        bf16_t* base = (bf16_t*)(ra + RA_KS + (size_t)(pn - 9) * (8 * MiB) + (size_t)bj * (4 * MiB));
                        *(u32x4*)(base + (size_t)row * 128 + wc * 32 + 8 * fq) = pack8(v0, v1);
                    } else {
                        if (bj == 0 && wc == 0) {
                            if (fq == 0) { *(f32x4*)(FL + (size_t)row * 8) = v0; *(f32x4*)(FL + (size_t)row * 8 + 4) = v1; }
                            else { f32x4 s0, s1;
#pragma unroll
                                for (int i = 0; i < 4; ++i) { s0[i] = 1.f / (1.f + __expf(-v0[i])); s1[i] = 1.f / (1.f + __expf(-v1[i])); }
                                float* gp = GATE + (size_t)row * 24 + 8 * (fq - 1); *(f32x4*)gp = s0; *(f32x4*)(gp + 4) = s1; }
                        }
                    }
                }
                asm volatile("" ::: "memory");
            }
    }
};

struct EpiOddIn {
    static constexpr bool PERM = true, AFTER_DRAIN = false;
    unsigned char* ws;
    __device__ __forceinline__ void operator()(const f32x4 (&acc)[2][2][4][2], const Unit& u, int wr, int wc, int fr, int fq) const {
        const int pn = u.pn, row0 = u.pm * BM + wr * 64 + fr;
        const bool ropewave = ((wc & 1) == 0) && pn < 8;
        bf16_t* base = (bf16_t*)(ws + WS_RA + (size_t)(pn >> 2) * (32 * MiB));
        const float* const COS = (const float*)(ws + WS_RS + RS_COS); const float* const SIN = (const float*)(ws + WS_RS + RS_SIN);
#pragma unroll
        for (int ai = 0; ai < 2; ++ai)
#pragma unroll
            for (int m = 0; m < 4; ++m) {
                const int row = row0 + ai * HALF + m * 16;
                const float* cs = COS + (size_t)row * 8; const float* sn = SIN + (size_t)row * 8;
#pragma unroll
                for (int bj = 0; bj < 2; ++bj) {
                    f32x4 v0 = acc[ai][bj][m][0], v1 = acc[ai][bj][m][1];
                    if (ropewave) rope8(v0, v1, cs, sn, fq);
                    if (pn < 4) { v0 = v0 * QSCALE; v1 = v1 * QSCALE; }
                    *(u32x4*)(base + (size_t)row * 1024 + (pn & 3) * 256 + bj * HALF + wc * 32 + 8 * fq) = pack8(v0, v1);
                }
                asm volatile("" ::: "memory");
            }
    }
};

struct EpiCross {
    static constexpr bool PERM = true, AFTER_DRAIN = false;
    bf16_t *CQ, *MEMKV;
    __device__ __forceinline__ void operator()(const f32x4 (&acc)[2][2][4][2], const Unit& u, int wr, int wc, int fr, int fq) const {
        const int pn = u.pn, row0 = u.pm * BM + wr * 64 + fr;
#pragma unroll
        for (int ai = 0; ai < 2; ++ai)
#pragma unroll
            for (int m = 0; m < 4; ++m) {
                const int row = row0 + ai * HALF + m * 16;
#pragma unroll
                for (int bj = 0; bj < 2; ++bj) {
                    f32x4 v0 = acc[ai][bj][m][0], v1 = acc[ai][bj][m][1];
                    const int tc = bj * HALF + wc * 32 + 8 * fq;
                    if (pn == 0) { v0 = v0 * QSCALE; v1 = v1 * QSCALE; *(u32x4*)(CQ + (size_t)row * 256 + tc) = pack8(v0, v1); }
                    else *(u32x4*)(MEMKV + (size_t)(row - MTOK) * 512 + (pn - 1) * 256 + tc) = pack8(v0, v1);
                }
            }
    }
};

struct EpiSwiGLU {
    static constexpr bool PERM = true, AFTER_DRAIN = false;
    bf16_t* H; int ldc;
    __device__ __forceinline__ void operator()(const f32x4 (&acc)[2][2][4][2], const Unit& u, int wr, int wc, int fr, int fq) const {
        const int row0 = u.pm * BM + wr * 64 + fr, col0 = u.pn * HALF + wc * 32 + 8 * fq;
#pragma unroll
        for (int ai = 0; ai < 2; ++ai)
#pragma unroll
            for (int m = 0; m < 4; ++m) {
                f32x4 o[2];
#pragma unroll
                for (int n = 0; n < 2; ++n) { const f32x4 g = acc[ai][0][m][n], up = acc[ai][1][m][n];
#pragma unroll
                    for (int i = 0; i < 4; ++i) { const float e = __builtin_amdgcn_exp2f(-g[i] * 1.4426950408889634f); o[n][i] = g[i] * __builtin_amdgcn_rcpf(1.f + e) * up[i]; } }
                *(u32x4*)(H + (size_t)(row0 + ai * HALF + m * 16) * ldc + col0) = pack8(o[0], o[1]);
            }
    }
};

struct CrossOrder {
    int G, c;
    __device__ __forceinline__ bool next(int i, Unit& u) const { const int L = i * G + c; if (L >= 72) return false; if (L < 64) { u.pm = L; u.pn = 0; } else { u.pm = 64 + ((L - 64) >> 1); u.pn = 1 + ((L - 64) & 1); } return true; }
    __device__ __forceinline__ void a_ready(const Unit&) const {}
    __device__ __forceinline__ void done(const Unit&) const {}
};
struct CmpOrder {
    int G, c;
    __device__ __forceinline__ bool next(int i, Unit& u) const { const int L = i * G + c; if (L >= 16) return false; u.pm = L; u.pn = L >> 3; return true; }
    __device__ __forceinline__ void a_ready(const Unit&) const {}
    __device__ __forceinline__ void done(const Unit&) const {}
};
template <class Epi, class Sched, bool ALIGN_EPI = false, bool SP2 = false>
__device__ __forceinline__ void gemm_phase(PG8_LAS unsigned char* lds, const Gemm g, const Sched& S, const Epi& E) {
    const int tid = opaque_tid(), wid = __builtin_amdgcn_readfirstlane(tid >> 6), lane = tid & 63, wr = wid >> 2, wc = wid & 3, fr = lane & 15, fq = lane >> 4;
    const int K = g.K, nt = K / BK;
    unsigned voffA[2], voffB[2];
#pragma unroll
    for (int i = 0; i < 2; ++i) { int R, C; stage_rc(tid * 16 + i * 8192, R, C); const int Rb = Epi::PERM ? ((R & ~31) + perm32(R & 31)) : R;
        voffA[i] = (unsigned)(R * K + C) * 2u; voffB[i] = (unsigned)(Rb * K + C) * 2u; }
    const size_t kstep = (size_t)(BK * 2);
    const size_t hstep = (size_t)HALF * K * 2;
    const size_t tstep = 2 * hstep;
    const unsigned ldsw = (unsigned)wid * 1024u;
    const int aoff = lds_byte(wr * 64 + fr, fq * 8), boff = lds_byte(wc * 32 + fr, fq * 8);
#define PG8_SA(b, h) (((b) * 2 + (h)) * HTB)
#define PG8_SB(b, h) ((4 + (b) * 2 + (h)) * HTB)
#define PG8_STAGE(bufoff, gbase, voff) do { _Pragma("unroll") for (int _i = 0; _i < 2; ++_i) \
        __builtin_amdgcn_global_load_lds((const unsigned*)((const char*)(gbase) + (voff)[_i]), (PG8_LAS unsigned*)(lds + (bufoff) + ldsw + _i * 8192), 16, 0, 0); } while (0)
#define PG8_LDA(dst, b, h) do { _Pragma("unroll") for (int m = 0; m < 4; ++m) _Pragma("unroll") for (int k = 0; k < 2; ++k) dst[m][k] = *(const PG8_LAS bf16x8*)(lds + PG8_SA(b, h) + aoff + m * 2048 + k * 1024); } while (0)
#define PG8_LDB(dst, b, h) do { _Pragma("unroll") for (int n = 0; n < 2; ++n) _Pragma("unroll") for (int k = 0; k < 2; ++k) dst[n][k] = *(const PG8_LAS bf16x8*)(lds + PG8_SB(b, h) + boff + n * 2048 + k * 1024); } while (0)
#define PG8_MMA(ai, bj, At, Bt) do { __builtin_amdgcn_s_setprio(1); _Pragma("unroll") for (int m = 0; m < 4; ++m) _Pragma("unroll") for (int n = 0; n < 2; ++n) _Pragma("unroll") for (int k = 0; k < 2; ++k) \
        acc[ai][bj][m][n] = __builtin_amdgcn_mfma_f32_16x16x32_bf16(Bt[n][k], At[m][k], acc[ai][bj][m][n], 0, 0, 0); __builtin_amdgcn_s_setprio(0); } while (0)
#define PG8_WAIT_V(n) asm volatile("s_waitcnt vmcnt(" #n ")" ::: "memory")
#define PG8_WAIT_L(n) asm volatile("s_waitcnt lgkmcnt(" #n ")" ::: "memory")
#define PG8_BAR __builtin_amdgcn_s_barrier()
#define PG8_SCHED __builtin_amdgcn_sched_barrier(0)
    Unit cur, nxt; int ui = 0;
    if (!S.next(0, cur)) return;
    f32x4 acc[2][2][4][2];
#pragma unroll
    for (int a = 0; a < 2; ++a)
#pragma unroll
        for (int b = 0; b < 2; ++b)
#pragma unroll
            for (int m = 0; m < 4; ++m)
#pragma unroll
                for (int n = 0; n < 2; ++n) acc[a][b][m][n] = (f32x4){0.f, 0.f, 0.f, 0.f};
    bf16x8 At[4][2], B0[2][2], B1[2][2];
    const char* cA = (const char*)g.A + (size_t)cur.pm * tstep; const char* cB = (const char*)g.Bt + (size_t)cur.pn * tstep;
    S.a_ready(cur);
    if constexpr (SP2) {
        PG8_STAGE(PG8_SB(0, 0), cB, voffB); PG8_STAGE(PG8_SB(0, 1), cB + hstep, voffB); PG8_STAGE(PG8_SA(0, 0), cA, voffA); PG8_STAGE(PG8_SA(0, 1), cA + hstep, voffA);
        if (wr == 1) PG8_BAR;
        PG8_WAIT_V(2); PG8_BAR;
        PG8_STAGE(PG8_SB(1, 0), cB + kstep, voffB); PG8_STAGE(PG8_SA(1, 0), cA + kstep, voffA); PG8_STAGE(PG8_SB(1, 1), cB + hstep + kstep, voffB);
        PG8_WAIT_V(6); PG8_BAR;
    } else {
        PG8_STAGE(PG8_SB(0, 0), cB, voffB); PG8_STAGE(PG8_SA(0, 0), cA, voffA); PG8_STAGE(PG8_SB(0, 1), cB + hstep, voffB); PG8_STAGE(PG8_SA(0, 1), cA + hstep, voffA);
        if (wr == 1) PG8_BAR;
        PG8_WAIT_V(4); PG8_BAR;
        PG8_STAGE(PG8_SB(1, 0), cB + kstep, voffB); PG8_STAGE(PG8_SA(1, 0), cA + kstep, voffA); PG8_STAGE(PG8_SB(1, 1), cB + hstep + kstep, voffB);
        PG8_WAIT_V(6); PG8_BAR;
    }
    for (;;) {
        const bool has_next = S.next(ui + 1, nxt);
        const char* nA = has_next ? (const char*)g.A + (size_t)nxt.pm * tstep : cA; const char* nB = has_next ? (const char*)g.Bt + (size_t)nxt.pn * tstep : cB;
        for (int t = 0; t < nt; t += 2) {
            const bool last = (t == nt - 2);
            const char* a1 = cA + (size_t)(t + 1) * kstep;
            const char* a2 = last ? nA : cA + (size_t)(t + 2) * kstep; const char* b2 = last ? nB : cB + (size_t)(t + 2) * kstep;
            const char* a3 = a2 + kstep; const char* b3 = b2 + kstep;
            if (last && has_next) S.a_ready(nxt);
            if constexpr (SP2) {
            PG8_LDB(B0, 0, 0); PG8_LDB(B1, 0, 1); PG8_SCHED; PG8_LDA(At, 0, 0); PG8_STAGE(PG8_SA(1, 1), a1 + hstep, voffA);
            PG8_WAIT_V(8); PG8_WAIT_L(0); PG8_BAR; PG8_MMA(0, 0, At, B0); PG8_MMA(0, 1, At, B1); PG8_BAR; PG8_SCHED;
            PG8_LDA(At, 0, 1); PG8_STAGE(PG8_SB(0, 0), b2, voffB); PG8_STAGE(PG8_SB(0, 1), b2 + hstep, voffB); PG8_STAGE(PG8_SA(0, 0), a2, voffA);
            PG8_WAIT_V(8); PG8_WAIT_L(0); PG8_BAR; PG8_MMA(1, 0, At, B0); PG8_MMA(1, 1, At, B1); PG8_BAR; PG8_SCHED;
            PG8_LDB(B0, 1, 0); PG8_LDB(B1, 1, 1); PG8_SCHED; PG8_LDA(At, 1, 0); PG8_STAGE(PG8_SA(0, 1), a2 + hstep, voffA);
            PG8_WAIT_V(8); PG8_WAIT_L(0); PG8_BAR; PG8_MMA(0, 0, At, B0); PG8_MMA(0, 1, At, B1); PG8_BAR; PG8_SCHED;
            PG8_LDA(At, 1, 1); PG8_STAGE(PG8_SB(1, 0), b3, voffB); PG8_STAGE(PG8_SB(1, 1), b3 + hstep, voffB); PG8_STAGE(PG8_SA(1, 0), a3, voffA);
            PG8_WAIT_V(8); PG8_WAIT_L(0); PG8_BAR; PG8_MMA(1, 0, At, B0); PG8_MMA(1, 1, At, B1); PG8_BAR; PG8_SCHED;
            } else {
            PG8_LDB(B0, 0, 0); PG8_SCHED; PG8_LDA(At, 0, 0); PG8_STAGE(PG8_SA(1, 1), a1 + hstep, voffA);
            PG8_WAIT_L(8); PG8_BAR; PG8_WAIT_L(0); PG8_MMA(0, 0, At, B0); PG8_BAR; PG8_SCHED;
            PG8_LDB(B1, 0, 1); PG8_STAGE(PG8_SB(0, 0), b2, voffB);
            PG8_BAR; PG8_WAIT_L(0); PG8_MMA(0, 1, At, B1); PG8_BAR;
            PG8_LDA(At, 0, 1); PG8_STAGE(PG8_SA(0, 0), a2, voffA);
            PG8_BAR; PG8_WAIT_L(0); PG8_MMA(1, 0, At, B0); PG8_BAR; PG8_SCHED;
            PG8_STAGE(PG8_SB(0, 1), b2 + hstep, voffB);
            PG8_WAIT_V(6); PG8_BAR; PG8_MMA(1, 1, At, B1); PG8_BAR;
            PG8_LDB(B0, 1, 0); PG8_SCHED; PG8_LDA(At, 1, 0); PG8_STAGE(PG8_SA(0, 1), a2 + hstep, voffA);
            PG8_WAIT_L(8); PG8_BAR; PG8_WAIT_L(0); PG8_MMA(0, 0, At, B0); PG8_BAR; PG8_SCHED;
            PG8_LDB(B1, 1, 1); PG8_STAGE(PG8_SB(1, 0), b3, voffB);
            PG8_BAR; PG8_WAIT_L(0); PG8_MMA(0, 1, At, B1); PG8_BAR;
            PG8_LDA(At, 1, 1); PG8_STAGE(PG8_SA(1, 0), a3, voffA);
            PG8_BAR; PG8_WAIT_L(0); PG8_MMA(1, 0, At, B0); PG8_BAR; PG8_SCHED;
            PG8_STAGE(PG8_SB(1, 1), b3 + hstep, voffB);
            PG8_WAIT_V(6); PG8_BAR; PG8_MMA(1, 1, At, B1); PG8_BAR;
            }
        }
        if constexpr (ALIGN_EPI) { if (wr == 0) PG8_BAR; }
        if constexpr (!Epi::AFTER_DRAIN) { E(acc, cur, wr, wc, fr, fq); S.done(cur); }
        if (!has_next) break;
#pragma unroll
        for (int a = 0; a < 2; ++a)
#pragma unroll
            for (int b = 0; b < 2; ++b)
#pragma unroll
                for (int m = 0; m < 4; ++m)
#pragma unroll
                    for (int n = 0; n < 2; ++n) acc[a][b][m][n] = (f32x4){0.f, 0.f, 0.f, 0.f};
        cur = nxt; cA = nA; cB = nB; ++ui;
        if constexpr (ALIGN_EPI) { if (wr == 1) PG8_BAR; }
    }
    PG8_WAIT_V(0);
    if constexpr (!ALIGN_EPI) { if (wr == 0) PG8_BAR; }
    PG8_BAR;
    if constexpr (Epi::AFTER_DRAIN) { E.fused(acc, cur, wr, wc, fr, fq, lds, wid, lane); S.done(cur); }
#undef PG8_SA
#undef PG8_SB
#undef PG8_STAGE
#undef PG8_LDA
#undef PG8_LDB
#undef PG8_MMA
#undef PG8_WAIT_V
#undef PG8_WAIT_L
#undef PG8_BAR
#undef PG8_SCHED
}
}
#define LAS __attribute__((address_space(3)))
namespace ga {
typedef unsigned short bf16_t;
typedef short bf16x8 __attribute__((ext_vector_type(8)));
typedef short s16x4 __attribute__((ext_vector_type(4)));
typedef float f32x4 __attribute__((ext_vector_type(4)));
typedef float f32x16 __attribute__((ext_vector_type(16)));
typedef unsigned u32x4 __attribute__((ext_vector_type(4)));
typedef unsigned u32x2 __attribute__((ext_vector_type(2)));
typedef short v4i16_t __attribute__((ext_vector_type(4)));
constexpr float NEG_INF = -INFINITY;
constexpr int L_K = 0, L_V = 16384, L_BIAS = 49152, L_OST = 65536, OST_PITCH = 144, OST_WAVE = 32 * OST_PITCH  , L_END = L_OST + 8 * OST_WAVE;

__device__ __forceinline__ int crow(int r, int hi) { return (r & 3) + 8 * (r >> 2) + 4 * hi; }
__device__ __forceinline__ unsigned cvtpk(float lo, float hi) { typedef float f2 __attribute__((ext_vector_type(2))); typedef __bf16 b2 __attribute__((ext_vector_type(2))); f2 v = {lo, hi}; b2 b = __builtin_convertvector(v, b2); return __builtin_bit_cast(unsigned, b); }
__device__ __forceinline__ float xmax(float m) { auto rr = __builtin_amdgcn_permlane32_swap(__float_as_uint(m), __float_as_uint(m), false, false); return fmaxf(__uint_as_float(rr[0]), __uint_as_float(rr[1])); }
__device__ __forceinline__ float xsum(float m) { auto rr = __builtin_amdgcn_permlane32_swap(__float_as_uint(m), __float_as_uint(m), false, false); return __uint_as_float(rr[0]) + __uint_as_float(rr[1]); }

__device__ __forceinline__ void qkt(f32x16& p0, f32x16& p1, const LAS unsigned char* Kslot, const bf16x8 (&qr)[4], int r32, int hi) {
    const LAS unsigned char* kb = Kslot + hi * 1024 + r32 * 16;
    f32x16 z;
#pragma unroll
    for (int r = 0; r < 16; ++r) z[r] = 0.f;
    p0 = z; p1 = z;
#pragma unroll
    for (int d0 = 0; d0 < 4; ++d0) {
        const bf16x8 b0 = *(const LAS bf16x8*)(kb + d0 * 2048);
        const bf16x8 b1 = *(const LAS bf16x8*)(kb + d0 * 2048 + 512);
        p0 = __builtin_amdgcn_mfma_f32_32x32x16_bf16(b0, qr[d0], p0, 0, 0, 0);
        p1 = __builtin_amdgcn_mfma_f32_32x32x16_bf16(b1, qr[d0], p1, 0, 0, 0);
    }
}
__device__ __forceinline__ s16x4 vtr(const LAS unsigned char* p) { return __builtin_bit_cast(s16x4, __builtin_amdgcn_ds_read_tr16_b64_v4i16((LAS v4i16_t*)p)); }
template <int NDB> __device__ __forceinline__ void pvT(f32x16 (&oT)[NDB], const LAS unsigned char* vb, const bf16x8 (&pa)[4]) {
#pragma unroll
    for (int d0 = 0; d0 < NDB; ++d0) {
#pragma unroll
        for (int ks = 0; ks < 4; ++ks) {
            const s16x4 lo = vtr(vb + d0 * 4096 + ks * 1024), hh = vtr(vb + d0 * 4096 + ks * 1024 + 512);
            const bf16x8 vf = {lo[0], lo[1], lo[2], lo[3], hh[0], hh[1], hh[2], hh[3]};
            oT[d0] = __builtin_amdgcn_mfma_f32_32x32x16_bf16(vf, pa[ks], oT[d0], 0, 0, 0);
        }
    }
}
__device__ __forceinline__ void pack_p(bf16x8 (&pa)[4], const f32x16& p0, const f32x16& p1) {
    u32x4 w;
    w.x = cvtpk(p0[0], p0[1]); w.y = cvtpk(p0[2], p0[3]); w.z = cvtpk(p0[4], p0[5]); w.w = cvtpk(p0[6], p0[7]); pa[0] = __builtin_bit_cast(bf16x8, w);
    w.x = cvtpk(p0[8], p0[9]); w.y = cvtpk(p0[10], p0[11]); w.z = cvtpk(p0[12], p0[13]); w.w = cvtpk(p0[14], p0[15]); pa[1] = __builtin_bit_cast(bf16x8, w);
    w.x = cvtpk(p1[0], p1[1]); w.y = cvtpk(p1[2], p1[3]); w.z = cvtpk(p1[4], p1[5]); w.w = cvtpk(p1[6], p1[7]); pa[2] = __builtin_bit_cast(bf16x8, w);
    w.x = cvtpk(p1[8], p1[9]); w.y = cvtpk(p1[10], p1[11]); w.z = cvtpk(p1[12], p1[13]); w.w = cvtpk(p1[14], p1[15]); pa[3] = __builtin_bit_cast(bf16x8, w);
}
__device__ __forceinline__ void mask_gt(f32x16& p0, f32x16& p1, int lim, int hi) {
#pragma unroll
    for (int r = 0; r < 16; ++r) { const int kv = crow(r, hi); if (kv > lim) p0[r] = NEG_INF; if (kv + 32 > lim) p1[r] = NEG_INF; }
}
__device__ __forceinline__ void mask_le(f32x16& p0, f32x16& p1, int lim, int hi) {
#pragma unroll
    for (int r = 0; r < 16; ++r) { const int kv = crow(r, hi); if (kv <= lim) p0[r] = NEG_INF; if (kv + 32 <= lim) p1[r] = NEG_INF; }
}
__device__ __forceinline__ void mask_all(f32x16& p0, f32x16& p1) {
#pragma unroll
    for (int r = 0; r < 16; ++r) { p0[r] = NEG_INF; p1[r] = NEG_INF; }
}

template <class Pol>
__device__ __forceinline__ void attn_core(const Pol& P, LAS unsigned char* shm, f32x16 (&oT)[Pol::DV / 32]) {
    constexpr int DV = Pol::DV, NDB = DV / 32, NVP = DV / 64, VSLOT = 128 * DV;
    const int tid = opaque_tid(), lane = tid & 63, r32 = lane & 31, hi = lane >> 5, wid = __builtin_amdgcn_readfirstlane(tid >> 6);
    LAS unsigned char* Ks = shm + L_K; LAS unsigned char* Vs = shm + L_V;
    bf16x8 qr[4];
    { const bf16_t* qp = P.qrow(wid, r32);
#pragma unroll
      for (int d0 = 0; d0 < 4; ++d0) qr[d0] = *(const bf16x8*)(qp + d0 * 16 + hi * 8); }
#pragma unroll
    for (int i = 0; i < NDB; ++i)
#pragma unroll
        for (int r = 0; r < 16; ++r) oT[i][r] = 0.f;
    float m = NEG_INF, l = 0.f;
    const int nt = P.nt;
    const bf16_t* kg = P.Kp + (size_t)lane * P.kpitch + wid * 8;
    const bf16_t* vg = P.Vp + (size_t)(16 * (wid & 3) + (lane >> 2)) * P.vpitch + 32 * (wid >> 2) + 8 * (lane & 3);
    const size_t kstep = (size_t)64 * P.kpitch, vstep = (size_t)64 * P.vpitch;
    const int sto = wid * 1024 + lane * 16;
    const LAS unsigned char* vb0 = Vs + ((lane >> 4) & 1) * 32 + (lane & 3) * 8 + (4 * hi + ((lane & 15) >> 2)) * 64;
    u32x4 kreg, vreg[NVP];
    kreg = *(const u32x4*)kg;
#pragma unroll
    for (int i = 0; i < NVP; ++i) vreg[i] = *(const u32x4*)(vg + 64 * i);
    *(LAS u32x4*)(Ks + sto) = kreg;
#pragma unroll
    for (int i = 0; i < NVP; ++i) *(LAS u32x4*)(Vs + i * 8192 + sto) = vreg[i];
    __syncthreads();
    for (int t = 0; t < nt; ++t) {
        const int s = t & 1;
        if (t + 1 < nt) {
            kreg = *(const u32x4*)(kg + (size_t)(t + 1) * kstep);
#pragma unroll
            for (int i = 0; i < NVP; ++i) vreg[i] = *(const u32x4*)(vg + (size_t)(t + 1) * vstep + 64 * i);
        }
        f32x16 p0, p1;
        qkt(p0, p1, Ks + s * 8192, qr, r32, hi);
        P.mask(p0, p1, t, wid, r32, hi);
        float mx = fmaxf(p0[0], p1[0]);
#pragma unroll
        for (int r = 1; r < 16; ++r) mx = fmaxf(mx, fmaxf(p0[r], p1[r]));
        mx = xmax(mx);
        const float mnew = fmaxf(m, mx);
        const float msafe = (mnew == NEG_INF) ? 0.f : mnew;
        const float alpha = __builtin_amdgcn_exp2f(m - msafe);
        m = mnew;
        float rs = 0.f;
#pragma unroll
        for (int r = 0; r < 16; ++r) { p0[r] = __builtin_amdgcn_exp2f(p0[r] - msafe); p1[r] = __builtin_amdgcn_exp2f(p1[r] - msafe); rs += p0[r] + p1[r]; }
        l = l * alpha + rs;
        if (!__all(alpha == 1.f)) {
#pragma unroll
            for (int i = 0; i < NDB; ++i)
#pragma unroll
                for (int r = 0; r < 16; ++r) oT[i][r] *= alpha;
        }
        bf16x8 pa[4];
        pack_p(pa, p0, p1);
        pvT<NDB>(oT, vb0 + s * VSLOT, pa);
        if (t + 1 < nt) {
            *(LAS u32x4*)(Ks + (s ^ 1) * 8192 + sto) = kreg;
#pragma unroll
            for (int i = 0; i < NVP; ++i) *(LAS u32x4*)(Vs + (s ^ 1) * VSLOT + i * 8192 + sto) = vreg[i];
        }
        __syncthreads();
    }
    const float lt = xsum(l);
    const float inv = lt > 0.f ? 1.f / lt : 0.f;
#pragma unroll
    for (int i = 0; i < NDB; ++i)
#pragma unroll
        for (int r = 0; r < 16; ++r) oT[i][r] *= inv;
}

template <class RowPtr>
__device__ __forceinline__ void store_group(const f32x16& o0, const f32x16& o1, LAS unsigned char* stg, int lane, const RowPtr& dst) {
    const int r32 = lane & 31, hi = lane >> 5;
#pragma unroll
    for (int g4 = 0; g4 < 4; ++g4) {
        u32x2 w; w.x = cvtpk(o0[4 * g4], o0[4 * g4 + 1]); w.y = cvtpk(o0[4 * g4 + 2], o0[4 * g4 + 3]);
        *(LAS u32x2*)(stg + r32 * OST_PITCH + (8 * g4 + 4 * hi) * 2) = w;
        w.x = cvtpk(o1[4 * g4], o1[4 * g4 + 1]); w.y = cvtpk(o1[4 * g4 + 2], o1[4 * g4 + 3]);
        *(LAS u32x2*)(stg + r32 * OST_PITCH + (32 + 8 * g4 + 4 * hi) * 2) = w;
    }
    asm volatile("s_waitcnt lgkmcnt(0)" ::: "memory");
#pragma unroll
    for (int i = 0; i < 4; ++i) { const int row = i * 8 + (lane >> 3), ch = lane & 7;
        const u32x4 v = *(const LAS u32x4*)(stg + row * OST_PITCH + ch * 16);
        *(u32x4*)(dst(row) + ch * 8) = v; }
    asm volatile("s_waitcnt lgkmcnt(0)" ::: "memory");
}
}
constexpr int NWAVES = 8;
constexpr int CW_BAR = 4096;
constexpr int MISC_OFF = 0, RING_OFF = 1024, RING_BYTES = 152 * 1024, LDS_BYTES = RING_OFF + RING_BYTES;

#define GAS __attribute__((address_space(1)))
typedef unsigned short bf16;
typedef unsigned v4u __attribute__((ext_vector_type(4)));
typedef float f32x4 __attribute__((ext_vector_type(4)));
typedef float f32x16 __attribute__((ext_vector_type(16)));
typedef short bf16x8 __attribute__((ext_vector_type(8)));
typedef GAS unsigned gu32;
typedef GAS unsigned long long gu64;
#define RLX_AGENT __ATOMIC_RELAXED, __HIP_MEMORY_SCOPE_AGENT
#define LDS_WAIT() asm volatile("s_waitcnt lgkmcnt(0)" ::: "memory")
#define VM_WAIT() asm volatile("s_waitcnt vmcnt(0)" ::: "memory")
__device__ __forceinline__ unsigned f2bf(float f) { unsigned u = __builtin_bit_cast(unsigned, f); return (u + 0x7fffu + ((u >> 16) & 1u)) >> 16; }
__device__ __forceinline__ unsigned pk2(float lo, float hi) { return f2bf(lo) | (f2bf(hi) << 16); }
__device__ __forceinline__ float bf2f(unsigned short h) { return __builtin_bit_cast(float, (unsigned)h << 16); }
__device__ __forceinline__ float wave_sum(float v) {
#pragma unroll
    for (int o = 1; o < 64; o <<= 1) v += __shfl_xor(v, o);
    return v;
}
#define XB_TMO      128
#define XB_XCNT(j)  (256  + 64 * (j))
#define XB_XSUB(j)  (1280 + 64 * (j))
#define XB_XGEN(j)  (2304 + 64 * (j))
#define XB_TOP      3328
#define XB_TOPGEN   3392
#define XCD_BAR_WORDS 3456
#define XB_SPIN_CAP (1u << 18)

__device__ __forceinline__ unsigned xb_ld(unsigned* p)              { return __hip_atomic_load(p, __ATOMIC_RELAXED, __HIP_MEMORY_SCOPE_AGENT); }
__device__ __forceinline__ unsigned xb_add(unsigned* p, unsigned v) { return __hip_atomic_fetch_add(p, v, __ATOMIC_RELAXED, __HIP_MEMORY_SCOPE_AGENT); }
__device__ __forceinline__ unsigned xb_xcc_id() { return (unsigned)__builtin_amdgcn_s_getreg((3 << 11) | 20) & 0xFu; }
#define XB_SPIN(cond, bar) do { unsigned _sp = 0; while (cond) { __builtin_amdgcn_s_sleep(1); \
    if ((++_sp & 255u) == 0u) { if (xb_ld(&(bar)[XB_TMO])) break; if (_sp > XB_SPIN_CAP) { atomicAdd(&(bar)[XB_TMO], 1u); break; } } } } while (0)

struct XcdBarrier {
    unsigned* bar; unsigned x;
    volatile LAS unsigned* st;
};

__device__ __forceinline__ XcdBarrier xcd_barrier_post(unsigned* bar, volatile LAS unsigned* st) {
    XcdBarrier b; b.bar = bar; b.x = xb_xcc_id(); b.st = st;
    if (threadIdx.x == 0) (void)xb_add(&bar[XB_XCNT(b.x)], 1u);
    return b;
}
__device__ __forceinline__ void xcd_barrier_complete(unsigned* bar, unsigned x, unsigned& nloc, unsigned& nx) {
    const unsigned G = gridDim.x * gridDim.y * gridDim.z;
    unsigned sum, cnt, mine, sp = 0u;
    for (;;) {
        sum = 0u; cnt = 0u; mine = 0u;
#pragma unroll
        for (unsigned j = 0; j < 16; ++j) { const unsigned c = xb_ld(&bar[XB_XCNT(j)]); sum += c; cnt += (c > 0u) ? 1u : 0u; mine = (j == x) ? c : mine; }
        if (sum == G) break;
        __builtin_amdgcn_s_sleep(1);
        if ((++sp & 255u) == 0u) { if (xb_ld(&bar[XB_TMO])) break; if (sp > XB_SPIN_CAP) { atomicAdd(&bar[XB_TMO], 1u); break; } }
    }
    nloc = mine > 0u ? mine : 1u; nx = cnt > 0u ? cnt : 1u;
}

__device__ __forceinline__ void xcd_barrier(const XcdBarrier& b) {
    asm volatile("s_waitcnt vmcnt(0)" ::: "memory");
    __syncthreads();
    if (threadIdx.x == 0) {
        unsigned* bar = b.bar;
        __builtin_amdgcn_s_waitcnt(0);
        unsigned nloc = b.st[0], nx = b.st[1];
        if (nloc == 0u) { xcd_barrier_complete(bar, b.x, nloc, nx); b.st[0] = nloc; b.st[1] = nx; }
        const unsigned old = xb_add(&bar[XB_XSUB(b.x)], 1u);
        const unsigned gen = old / nloc;
        if (old + 1u == (gen + 1u) * nloc) {
            __builtin_amdgcn_fence(__ATOMIC_RELEASE, "agent");
            asm volatile("s_waitcnt vmcnt(0)" ::: "memory");
            const unsigned og = xb_add(&bar[XB_TOP], 1u);
            const unsigned tg = og / nx;
            if (og + 1u == (tg + 1u) * nx) xb_add(&bar[XB_TOPGEN], 1u);
            else XB_SPIN(xb_ld(&bar[XB_TOPGEN]) == tg, bar);
            __builtin_amdgcn_fence(__ATOMIC_ACQUIRE, "agent");
            xb_add(&bar[XB_XGEN(b.x)], 1u);
            asm volatile("s_waitcnt vmcnt(0)" ::: "memory");
        } else {
            XB_SPIN(xb_ld(&bar[XB_XGEN(b.x)]) == gen, bar);
            __builtin_amdgcn_fence(__ATOMIC_ACQUIRE, "agent");
            asm volatile("s_waitcnt vmcnt(0)" ::: "memory");
        }
    }
    __syncthreads();
}
struct Frame {
    LAS unsigned char* lds;
    int tid, lane, wave;
    int vcu, G;
    unsigned char* ws;
};
#define GW_OF(F) ((F).vcu * NWAVES + (F).wave)
#define NGW_OF(F) ((F).G * NWAVES)

__device__ __forceinline__ void conv_seg(Frame& F, int& off, const float* W, int K, int ldw, int c0, int nc, bf16* WT, int rbase, int grp, int gstride) {
    LAS float* scr = (LAS float*)(F.lds + RING_OFF + F.wave * 16384);
    const int NGW = NGW_OF(F), gw = GW_OF(F), lane = F.lane;
    const int nblk = (nc + 31) >> 5, nitems = (K >> 6) * nblk;
    int first = (gw - (off % NGW) + NGW) % NGW;
    for (int it = first; it < nitems; it += NGW) {
        const int kb = it / nblk, nb = it % nblk, k0 = 64 * kb, n0 = 32 * nb;
        const int nn = n0 + (lane & 31); const bool ok = nn < nc;
#pragma unroll 8
        for (int i = 0; i < 32; ++i) { const int kk = 2 * i + (lane >> 5); scr[kk * 33 + (lane & 31)] = ok ? W[(size_t)(k0 + kk) * ldw + c0 + nn] : 0.f; }
        LDS_WAIT(); asm volatile("" ::: "memory");
        const int c = lane & 7;
#pragma unroll
        for (int j = 0; j < 4; ++j) { const int n = (lane >> 3) + 8 * j; const LAS float* s = scr + (8 * c) * 33 + n;
            v4u o; o.x = pk2(s[0 * 33], s[1 * 33]); o.y = pk2(s[2 * 33], s[3 * 33]); o.z = pk2(s[4 * 33], s[5 * 33]); o.w = pk2(s[6 * 33], s[7 * 33]);
            const int ng = n0 + n;
            if (ng < nc) *(GAS v4u*)(WT + (size_t)(rbase + (ng / grp) * gstride + (ng % grp)) * K + k0 + 8 * c) = o; }
        LDS_WAIT(); asm volatile("" ::: "memory");
    }
    off += nitems;
}

struct Inputs {
    const float *x, *mem; const int* positions; const float *sandwich_g, *mem_norm_g, *ev_w_in, *ev_fbias, *ev_pos_k, *ev_w1_k, *ev_w2_k, *ev_pos_v, *ev_w1_v, *ev_w2_v, *ev_w_out,
        *od_w_in, *od_lambda, *od_subln_g, *od_w_out, *ca_wq, *ca_wk, *ca_wv, *ca_wo, *ffn_wg, *ffn_wu, *ffn_wd;
};

typedef const __attribute__((address_space(4))) Inputs* KInputsP;
__device__ __forceinline__ void conv_layer(Frame& F, KInputsP I, int layer) {
    unsigned char* wb = F.ws + WS_WB; int off = 0;
    const int e = layer >> 1;
    if ((layer & 1) == 0) {
        const float* W = I->ev_w_in + (size_t)e * DM * EVEN_IN; bf16* WT = (bf16*)(wb + WB_IN);
        conv_seg(F, off, W, DM, EVEN_IN, 0, 1536, WT, 0, 4096, 0);
        conv_seg(F, off, W, DM, EVEN_IN, 1544, 1280, WT, 1536, 4096, 0);
        conv_seg(F, off, W, DM, EVEN_IN, 1536, 8, WT, 2816, 4096, 0);
        conv_seg(F, off, W, DM, EVEN_IN, 2824, 24, WT, 2824, 4096, 0);
        {
            const int NGW = NGW_OF(F), gw = GW_OF(F);
            for (int r = gw; r < 224; r += NGW) { GAS v4u* p = (GAS v4u*)(WT + (size_t)(2848 + r) * DM) + F.lane; const v4u z = {0u, 0u, 0u, 0u}; p[0] = z; p[64] = z; }
        }
        conv_seg(F, off, I->ev_w_out + (size_t)e * DM * DM, DM, DM, 0, DM, (bf16*)(wb + WB_OUT), 0, 4096, 0);
        bf16* WC = (bf16*)(wb + WB_CMP);
        const float* w1k = I->ev_w1_k + (size_t)e * 2048 * 128; const float* w1v = I->ev_w1_v + (size_t)e * 2048 * 128;
        conv_seg(F, off, w1k, 1024, 128, 0, 128, WC, 0, 4096, 0);
        conv_seg(F, off, w1k + 1024 * 128, 1024, 128, 0, 128, WC, 128, 4096, 0);
        conv_seg(F, off, w1v, 1024, 128, 0, 128, WC, 256, 4096, 0);
        conv_seg(F, off, w1v + 1024 * 128, 1024, 128, 0, 128, WC, 384, 4096, 0);
        { const int NGW = NGW_OF(F), gw = GW_OF(F); float* B1 = (float*)(F.ws + WS_RS + RS_BIAS1);
          for (int o = gw; o < 256; o += NGW) { const int sel = o >> 7, j = o & 127; const float* pos = (sel ? I->ev_pos_v : I->ev_pos_k) + (size_t)e * 2048; const float* w1 = sel ? w1v : w1k;
              float s = 0.f; for (int i = F.lane; i < 2048; i += 64) s += pos[i] * w1[(size_t)i * 128 + j];
              s = wave_sum(s); if (F.lane == 0) B1[o] = s; } }
    } else {
        conv_seg(F, off, I->od_w_in + (size_t)e * DM * ODD_IN, DM, ODD_IN, 0, ODD_IN, (bf16*)(wb + WB_IN), 0, 4096, 0);
        conv_seg(F, off, I->od_w_out + (size_t)e * DM * DM, DM, DM, 0, DM, (bf16*)(wb + WB_OUT), 0, 4096, 0);
    }
    bf16* WQ = (bf16*)(wb + WB_CQKV);
    conv_seg(F, off, I->ca_wq + (size_t)layer * DM * 256, DM, 256, 0, 256, WQ, 0, 4096, 0);
    conv_seg(F, off, I->ca_wk + (size_t)layer * DM * 256, DM, 256, 0, 256, WQ, 256, 4096, 0);
    conv_seg(F, off, I->ca_wv + (size_t)layer * DM * 256, DM, 256, 0, 256, WQ, 512, 4096, 0);
    conv_seg(F, off, I->ca_wo + (size_t)layer * 256 * DM, 256, DM, 0, DM, (bf16*)(wb + WB_CO), 0, 4096, 0);
    bf16* WG = (bf16*)(wb + WB_GU);
    conv_seg(F, off, I->ffn_wg + (size_t)layer * DM * FFD, DM, FFD, 0, FFD, WG, 0, 128, 256);
    conv_seg(F, off, I->ffn_wu + (size_t)layer * DM * FFD, DM, FFD, 0, FFD, WG, 128, 128, 256);
    conv_seg(F, off, I->ffn_wd + (size_t)layer * FFD * DM, FFD, DM, 0, DM, (bf16*)(wb + WB_D), 0, 4096, 0);
}

__device__ __forceinline__ void norm_row_to_bf16(const float* xrow, const float* g, bf16* orow, int lane) {
    const GAS f32x4* xr = (const GAS f32x4*)xrow + lane; const GAS f32x4* gr = (const GAS f32x4*)g + lane;
    f32x4 v[4]; float s = 0.f;
#pragma unroll
    for (int j = 0; j < 4; ++j) { v[j] = xr[64 * j]; s += (v[j].x * v[j].x + v[j].y * v[j].y) + (v[j].z * v[j].z + v[j].w * v[j].w); }
    const float rstd = 1.f / sqrtf(wave_sum(s) * (1.f / DM) + RMS_EPS);
    GAS unsigned long long* o8 = (GAS unsigned long long*)orow + lane;
#pragma unroll
    for (int j = 0; j < 4; ++j) { const f32x4 gg = gr[64 * j]; const f32x4 h = v[j] * rstd * gg;
        o8[64 * j] = (unsigned long long)pk2(h.x, h.y) | ((unsigned long long)pk2(h.z, h.w) << 32); }
}
__device__ __forceinline__ void resid_norm_rows(Frame& F, const float* xin, const float* y, const float* gpost, const float* gnext, float* xout, bf16* xn) {
    const int NGW = NGW_OF(F), gw = GW_OF(F), lane = F.lane;
    for (int mrow = gw; mrow < MTOK; mrow += NGW) {
        const GAS f32x4* yr = (const GAS f32x4*)(y + (size_t)mrow * DM) + lane; const GAS f32x4* xr = (const GAS f32x4*)(xin + (size_t)mrow * DM) + lane;
        const GAS f32x4* gp = (const GAS f32x4*)gpost + lane;
        f32x4 yv[4], xv[4]; float s = 0.f;
#pragma unroll
        for (int j = 0; j < 4; ++j) { yv[j] = yr[64 * j]; xv[j] = xr[64 * j]; s += (yv[j].x * yv[j].x + yv[j].y * yv[j].y) + (yv[j].z * yv[j].z + yv[j].w * yv[j].w); }
        const float rstd = 1.f / sqrtf(wave_sum(s) * (1.f / DM) + RMS_EPS);
        GAS f32x4* xo = (GAS f32x4*)(xout + (size_t)mrow * DM) + lane; float s2 = 0.f;
#pragma unroll
        for (int j = 0; j < 4; ++j) { const f32x4 gg = gp[64 * j]; xv[j] = xv[j] + yv[j] * rstd * gg; xo[64 * j] = xv[j]; s2 += (xv[j].x * xv[j].x + xv[j].y * xv[j].y) + (xv[j].z * xv[j].z + xv[j].w * xv[j].w); }
        if (gnext) {
            const float rstd2 = 1.f / sqrtf(wave_sum(s2) * (1.f / DM) + RMS_EPS);
            const GAS f32x4* gn = (const GAS f32x4*)gnext + lane; GAS unsigned long long* o8 = (GAS unsigned long long*)(xn + (size_t)mrow * DM) + lane;
#pragma unroll
            for (int j = 0; j < 4; ++j) { const f32x4 gg = gn[64 * j]; const f32x4 h = xv[j] * rstd2 * gg;
                o8[64 * j] = (unsigned long long)pk2(h.x, h.y) | ((unsigned long long)pk2(h.z, h.w) << 32); }
        }
    }
}

__device__ __forceinline__ void rope_tables(Frame& F, const int* positions) {
    float* COS = (float*)(F.ws + WS_RS + RS_COS); float* SIN = (float*)(F.ws + WS_RS + RS_SIN);
    const int gt = (F.vcu * NWAVES + F.wave) * 64 + F.lane, NT = F.G * NWAVES * 64;
    for (int i = gt; i < MTOK * 8; i += NT) {
        const int tok = i >> 3, j = i & 7;
        const float inv = powf(500000.0f, -(float)(2 * j) / 16.0f);
        const float ang = (float)positions[tok] * inv;
        const double rev = (double)ang * 0.15915494309189535;
        const float fr = (float)(rev - rint(rev));
        COS[i] = __builtin_amdgcn_cosf(fr); SIN[i] = __builtin_amdgcn_sinf(fr);
    }
}

__device__ __forceinline__ void fox_scan_seq(Frame& F, int seq, const float* fbias) {
    const float* FL = (const float*)(F.ws + WS_RS + RS_FL); float* CB = (float*)(F.ws + WS_RS + RS_CB);
    LAS float* wsum = (LAS float*)(F.lds + RING_OFF);
    const int b = seq >> 3, h = seq & 7, tid = F.tid;
    const float bias = fbias[h];
    float v[8]; float run = 0.f;
#pragma unroll
    for (int i = 0; i < 8; ++i) { const int t = tid * 8 + i; const float z = FL[((size_t)(b * SEQ + t)) * 8 + h] + bias;
        const float lf = fminf(z, 0.f) - log1pf(expf(-fabsf(z))); run += lf; v[i] = run; }
    float inc = run;
#pragma unroll
    for (int o = 1; o < 64; o <<= 1) { const float n = __shfl_up(inc, o); if (F.lane >= o) inc += n; }
    if (F.lane == 63) wsum[F.wave] = inc;
    __syncthreads();
    float base = inc - run;
    for (int w = 0; w < F.wave; ++w) base += wsum[w];
#pragma unroll
    for (int i = 0; i < 8; ++i) CB[(size_t)seq * SEQ + tid * 8 + i] = -(base + v[i]) * LOG2E;
    __syncthreads();
}

__device__ __forceinline__ void compress_tail(Frame& F, const float* w2k, const float* w2v) {
    const float* U = (const float*)(F.ws + WS_RS + RS_U); const float* B1 = (const float*)(F.ws + WS_RS + RS_BIAS1);
    LAS float* hid = (LAS float*)(F.lds + RING_OFF + F.wave * 1024);
    const int NGW = NGW_OF(F), gw = GW_OF(F), lane = F.lane;
    for (int r = gw; r < 2 * 2048; r += NGW) {
        const int sel = r >> 11, bg = (r >> 8) & 7, c = r & 255;
        bf16* out = (bf16*)(F.ws + WS_RS + (sel ? RS_VCMP : RS_KCMP)) + ((size_t)bg * 256 + c) * 64;
        if (c == 255) { out[lane] = 0; continue; }
        const float* ut = U + ((size_t)(sel * 2048 + bg * 256 + c)) * 512 + sel * 256; const float* ub = ut + 512 + 128;
#pragma unroll
        for (int k = 0; k < 2; ++k) { const int j = lane + 64 * k; const float xv = ut[j] + ub[j] + B1[sel * 128 + j];
            const float uu = 0.7978845608028654f * (xv + 0.044715f * xv * xv * xv); const float th = 1.f - 2.f / (expf(2.f * uu) + 1.f);
            hid[j] = 0.5f * xv * (1.f + th); }
        LDS_WAIT(); asm volatile("" ::: "memory");
        const float* w2 = sel ? w2v : w2k; float acc = 0.f;
#pragma unroll 8
        for (int j = 0; j < 128; ++j) acc += hid[j] * w2[j * 64 + lane];
        out[lane] = (bf16)f2bf(acc);
        LDS_WAIT(); asm volatile("" ::: "memory");
    }
}

__device__ __forceinline__ void diff_combine(Frame& F, const float* lam_p, const float* subg, int layer) {
    bf16* O1 = (bf16*)(F.ws + WS_RB + RB_O); const bf16* O2 = (const bf16*)(F.ws + WS_RB + RB_O2);
    const int NGW = NGW_OF(F), gw = GW_OF(F), lane = F.lane;
    const float lam_init = 0.8f - 0.6f * expf(-0.3f * (float)layer);
    const float d1 = wave_sum(lam_p[lane] * lam_p[64 + lane]), d2 = wave_sum(lam_p[128 + lane] * lam_p[192 + lane]);
    const float lam = expf(d1) - expf(d2) + lam_init;
    const float post = 1.f - lam_init;
    float g[16];
#pragma unroll
    for (int i = 0; i < 16; ++i) g[i] = subg[(lane & 7) * 16 + i] * post;
    for (int mrow = gw; mrow < MTOK; mrow += NGW) {
        const GAS v4u* p1 = (const GAS v4u*)(O1 + (size_t)mrow * DM) + 2 * lane; const GAS v4u* p2 = (const GAS v4u*)(O2 + (size_t)mrow * DM) + 2 * lane;
        const v4u a0 = p1[0], a1 = p1[1], b0 = p2[0], b1 = p2[1];
        float o[16]; float s = 0.f;
        const unsigned aw[8] = {a0.x, a0.y, a0.z, a0.w, a1.x, a1.y, a1.z, a1.w}, bw[8] = {b0.x, b0.y, b0.z, b0.w, b1.x, b1.y, b1.z, b1.w};
#pragma unroll
        for (int i = 0; i < 8; ++i) { o[2 * i] = bf2f((unsigned short)(aw[i] & 0xffffu)) - lam * bf2f((unsigned short)(bw[i] & 0xffffu)); o[2 * i + 1] = bf2f((unsigned short)(aw[i] >> 16)) - lam * bf2f((unsigned short)(bw[i] >> 16));
            s += o[2 * i] * o[2 * i] + o[2 * i + 1] * o[2 * i + 1]; }
        s += __shfl_xor(s, 1); s += __shfl_xor(s, 2); s += __shfl_xor(s, 4);
        const float rstd = 1.f / sqrtf(s * (1.f / 128.f) + RMS_EPS);
        v4u w0, w1;
        w0.x = pk2(o[0] * rstd * g[0], o[1] * rstd * g[1]); w0.y = pk2(o[2] * rstd * g[2], o[3] * rstd * g[3]); w0.z = pk2(o[4] * rstd * g[4], o[5] * rstd * g[5]); w0.w = pk2(o[6] * rstd * g[6], o[7] * rstd * g[7]);
        w1.x = pk2(o[8] * rstd * g[8], o[9] * rstd * g[9]); w1.y = pk2(o[10] * rstd * g[10], o[11] * rstd * g[11]); w1.z = pk2(o[12] * rstd * g[12], o[13] * rstd * g[13]); w1.w = pk2(o[14] * rstd * g[14], o[15] * rstd * g[15]);
        GAS v4u* po = (GAS v4u*)(O1 + (size_t)mrow * DM) + 2 * lane; po[0] = w0; po[1] = w1;
    }
}
namespace ap {
using ga::bf16_t; using ga::f32x16; using ga::f32x4; using ga::u32x4; using ga::u32x2;

struct PolFox {
    static constexpr int DV = 64;
    const bf16_t* Kp; int kpitch; const bf16_t* Vp; int vpitch; int nt;
    const bf16_t* Qb; int qb; const LAS float* cb;
    __device__ __forceinline__ const bf16_t* qrow(int wid, int r32) const { return Qb + (size_t)(wid * 32 + r32) * 512; }
    __device__ __forceinline__ void mask(f32x16& p0, f32x16& p1, int t, int wid, int r32, int hi) const {
        const LAS float* c = cb + 64 * t + 4 * hi;
#pragma unroll
        for (int g4 = 0; g4 < 4; ++g4) { const f32x4 a = *(const LAS f32x4*)(c + 8 * g4), b = *(const LAS f32x4*)(c + 32 + 8 * g4);
#pragma unroll
            for (int i = 0; i < 4; ++i) { p0[4 * g4 + i] += a[i]; p1[4 * g4 + i] += b[i]; } }
        if (t >= 4 * qb) ga::mask_gt(p0, p1, wid * 32 + r32 - 64 * (t - 4 * qb), hi);
    }
};
__device__ __forceinline__ void fox_unit(Frame& F, int b, int h, int qb) {
    const bf16_t* QF = (const bf16_t*)(F.ws + WS_RA + RA_QF); const bf16_t* KF = (const bf16_t*)(F.ws + WS_RA + RA_KF); const bf16_t* VF = (const bf16_t*)(F.ws + WS_RA + RA_VF);
    bf16_t* O = (bf16_t*)(F.ws + WS_RB + RB_O); const float* CB = (const float*)(F.ws + WS_RS + RS_CB);
    LAS unsigned char* shm = F.lds + RING_OFF;
    LAS float* cbl = (LAS float*)(shm + ga::L_BIAS);
    const int nk = 256 * (qb + 1);
    for (int i = F.tid; i < nk; i += NWAVES * 64) cbl[i] = CB[(size_t)(b * 8 + h) * SEQ + i];
    PolFox P; P.Kp = KF + (size_t)b * SEQ * 512 + h * 64; P.kpitch = 512; P.Vp = VF + (size_t)b * SEQ * 512 + h * 64; P.vpitch = 512; P.nt = 4 * (qb + 1);
    P.Qb = QF + ((size_t)b * SEQ + 256 * qb) * 512 + h * 64; P.qb = qb; P.cb = cbl;
    f32x16 oT[2];
    ga::attn_core<PolFox>(P, shm, oT);
    bf16_t* ob = O + ((size_t)b * SEQ + 256 * qb + F.wave * 32) * DM + h * 64;
    ga::store_group(oT[0], oT[1], shm + ga::L_OST + F.wave * ga::OST_WAVE, F.lane, [ob](int row) { return ob + (size_t)row * DM; });
    __syncthreads();
}

struct PolDiff {
    static constexpr int DV = 128;
    const bf16_t* Kp; int kpitch; const bf16_t* Vp; int vpitch; int nt;
    const bf16_t* Qb; int qb;
    __device__ __forceinline__ const bf16_t* qrow(int wid, int r32) const { return Qb + (size_t)(wid * 32 + r32) * DM; }
    __device__ __forceinline__ void mask(f32x16& p0, f32x16& p1, int t, int wid, int r32, int hi) const {
        if (t >= 4 * qb) ga::mask_gt(p0, p1, wid * 32 + r32 - 64 * (t - 4 * qb), hi);
    }
};
__device__ __forceinline__ void diff_unit(Frame& F, int b, int hv, int qb) {
    const bf16_t* Q = (const bf16_t*)(F.ws + WS_RA + RA_Q); const bf16_t* K = (const bf16_t*)(F.ws + WS_RA + RA_K); const bf16_t* V = (const bf16_t*)(F.ws + WS_RA + RA_V);
    bf16_t* O = (bf16_t*)(F.ws + WS_RB + ((hv & 1) ? RB_O2 : RB_O));
    LAS unsigned char* shm = F.lds + RING_OFF;
    PolDiff P; P.Kp = K + (size_t)b * SEQ * DM + hv * 64; P.kpitch = DM; P.Vp = V + (size_t)b * SEQ * DM + (hv >> 1) * 128; P.vpitch = DM; P.nt = 4 * (qb + 1);
    P.Qb = Q + ((size_t)b * SEQ + 256 * qb) * DM + hv * 64; P.qb = qb;
    f32x16 oT[4];
    ga::attn_core<PolDiff>(P, shm, oT);
    bf16_t* ob = O + ((size_t)b * SEQ + 256 * qb + F.wave * 32) * DM + (hv >> 1) * 128;
    LAS unsigned char* stg = shm + ga::L_OST + F.wave * ga::OST_WAVE;
    ga::store_group(oT[0], oT[1], stg, F.lane, [ob](int row) { return ob + (size_t)row * DM; });
    ga::store_group(oT[2], oT[3], stg, F.lane, [ob](int row) { return ob + (size_t)row * DM + 64; });
    __syncthreads();
}

struct PolCross {
    static constexpr int DV = 64;
    const bf16_t* Kp; int kpitch; const bf16_t* Vp; int vpitch; int nt;
    const bf16_t* Qb;
    __device__ __forceinline__ const bf16_t* qrow(int wid, int r32) const { return Qb + (size_t)(wid * 32 + r32) * 256; }
    __device__ __forceinline__ void mask(f32x16&, f32x16&, int, int, int, int) const {}
};
__device__ __forceinline__ void cross_unit(Frame& F, int b, int h, int qb) {
    const bf16_t* CQ = (const bf16_t*)(F.ws + WS_RB + RB_CQ); bf16_t* CO = (bf16_t*)(F.ws + WS_RB + RB_CO); const bf16_t* MKV = (const bf16_t*)(F.ws + WS_RS + RS_MEMKV);
    LAS unsigned char* shm = F.lds + RING_OFF;
    PolCross P; P.Kp = MKV + (size_t)b * MEMT * 512 + h * 64; P.kpitch = 512; P.Vp = MKV + (size_t)b * MEMT * 512 + 256 + h * 64; P.vpitch = 512; P.nt = 4;
    P.Qb = CQ + ((size_t)b * SEQ + 256 * qb) * 256 + h * 64;
    f32x16 oT[2];
    ga::attn_core<PolCross>(P, shm, oT);
    bf16_t* ob = CO + ((size_t)b * SEQ + 256 * qb + F.wave * 32) * 256 + h * 64;
    ga::store_group(oT[0], oT[1], shm + ga::L_OST + F.wave * ga::OST_WAVE, F.lane, [ob](int row) { return ob + (size_t)row * 256; });
    __syncthreads();
}

struct PolSlc {
    static constexpr int DV = 64;
    const bf16_t* Kp; int kpitch; const bf16_t* Vp; int vpitch; int nt;
    const bf16_t* Qb; int qb; unsigned sel_lo, sel_hi;
    __device__ __forceinline__ const bf16_t* qrow(int wid, int r32) const { return Qb + (size_t)((wid & 1) * 32 + r32) * 512 + (wid >> 1) * 64; }
    __device__ __forceinline__ void mask(f32x16& p0, f32x16& p1, int t, int wid, int r32, int hi) const {
        const unsigned w = (t < 32) ? sel_lo : sel_hi; const bool on = (w >> (t & 31)) & 1u;
        if (!on) ga::mask_all(p0, p1);
        if (t == qb) ga::mask_gt(p0, p1, (wid & 1) * 32 + r32, hi);
    }
};
struct PolSwa {
    static constexpr int DV = 64;
    const bf16_t* Kp; int kpitch; const bf16_t* Vp; int vpitch; int nt;
    const bf16_t* Qb; int qb, t0;
    __device__ __forceinline__ const bf16_t* qrow(int wid, int r32) const { return Qb + (size_t)((wid & 1) * 32 + r32) * 512 + (wid >> 1) * 64; }
    __device__ __forceinline__ void mask(f32x16& p0, f32x16& p1, int t, int wid, int r32, int hi) const {
        const int tt = t0 + t, qrel = (wid & 1) * 32 + r32;
        if (tt == qb) ga::mask_gt(p0, p1, qrel, hi);
        if (tt == qb - 8) ga::mask_le(p0, p1, qrel, hi);
    }
};
__device__ __forceinline__ void nsa_main_unit(Frame& F, int b, int g, int qb) {
    const bf16_t* NQ = (const bf16_t*)(F.ws + WS_RA + RA_NQ); const bf16_t* KS = (const bf16_t*)(F.ws + WS_RA + RA_KS); const bf16_t* VS = (const bf16_t*)(F.ws + WS_RA + RA_VS);
    const bf16_t* KW = (const bf16_t*)(F.ws + WS_RA + RA_KW); const bf16_t* VW = (const bf16_t*)(F.ws + WS_RA + RA_VW);
    const bf16_t* OC = (const bf16_t*)(F.ws + WS_RB + RB_OC); bf16_t* O = (bf16_t*)(F.ws + WS_RB + RB_O);
    const float* GATE = (const float*)(F.ws + WS_RS + RS_GATE); const unsigned* SELM = (const unsigned*)(F.ws + WS_RS + RS_SELM);
    LAS unsigned char* shm = F.lds + RING_OFF;
    const int r32 = F.lane & 31, hi = F.lane >> 5, n = F.wave >> 1;
    const size_t tok = (size_t)b * SEQ + 64 * qb + (F.wave & 1) * 32 + r32;
    const bf16_t* Qb = NQ + ((size_t)b * SEQ + 64 * qb) * 512 + (4 * g) * 64;
    f32x16 oS[2], oW[2];
    { PolSlc P; P.Kp = KS + (size_t)b * SEQ * 128 + g * 64; P.kpitch = 128; P.Vp = VS + (size_t)b * SEQ * 128 + g * 64; P.vpitch = 128; P.nt = qb + 1; P.Qb = Qb; P.qb = qb;
      const unsigned* sp = SELM + ((size_t)(b * 2 + g) * SEQ + 64 * qb + (F.wave & 1) * 32 + r32) * 2; P.sel_lo = sp[0]; P.sel_hi = sp[1];
      ga::attn_core<PolSlc>(P, shm, oS); }
    { PolSwa P; const int t0 = qb > 8 ? qb - 8 : 0; P.Kp = KW + ((size_t)b * SEQ + 64 * t0) * 128 + g * 64; P.kpitch = 128; P.Vp = VW + ((size_t)b * SEQ + 64 * t0) * 128 + g * 64; P.vpitch = 128;
      P.nt = qb - t0 + 1; P.Qb = Qb; P.qb = qb; P.t0 = t0;
      ga::attn_core<PolSwa>(P, shm, oW); }
    const float g1 = GATE[tok * 24 + (4 * g + n) * 3 + 1], g2 = GATE[tok * 24 + (4 * g + n) * 3 + 2];
    const bf16_t* ocp = OC + tok * 512 + (4 * g + n) * 64;
#pragma unroll
    for (int d0 = 0; d0 < 2; ++d0)
#pragma unroll
        for (int g4 = 0; g4 < 4; ++g4) { const u32x2 w = *(const u32x2*)(ocp + 32 * d0 + 8 * g4 + 4 * hi);
            const float c0 = bf2f((unsigned short)(w.x & 0xffffu)), c1 = bf2f((unsigned short)(w.x >> 16)), c2 = bf2f((unsigned short)(w.y & 0xffffu)), c3 = bf2f((unsigned short)(w.y >> 16));
            oS[d0][4 * g4 + 0] = c0 + g1 * oS[d0][4 * g4 + 0] + g2 * oW[d0][4 * g4 + 0]; oS[d0][4 * g4 + 1] = c1 + g1 * oS[d0][4 * g4 + 1] + g2 * oW[d0][4 * g4 + 1];
            oS[d0][4 * g4 + 2] = c2 + g1 * oS[d0][4 * g4 + 2] + g2 * oW[d0][4 * g4 + 2]; oS[d0][4 * g4 + 3] = c3 + g1 * oS[d0][4 * g4 + 3] + g2 * oW[d0][4 * g4 + 3]; }
    bf16_t* ob = O + ((size_t)b * SEQ + 64 * qb + (F.wave & 1) * 32) * DM + 512 + (4 * g + n) * 64;
    ga::store_group(oS[0], oS[1], shm + ga::L_OST + F.wave * ga::OST_WAVE, F.lane, [ob](int row) { return ob + (size_t)row * DM; });
    __syncthreads();
}

constexpr int N3_K = 0, N3_V = 32768, N3_PH = 65536, N3_IMP = 131072, N3_CARRY = 147456, N3_END = N3_CARRY + 512;
static_assert(N3_END <= RING_BYTES, "N3 LDS");
__device__ __forceinline__ void nsa_cmp_unit(Frame& F, int b, int g, int qb) {
    const bf16_t* NQ = (const bf16_t*)(F.ws + WS_RA + RA_NQ); const bf16_t* KC = (const bf16_t*)(F.ws + WS_RS + RS_KCMP); const bf16_t* VC = (const bf16_t*)(F.ws + WS_RS + RS_VCMP);
    bf16_t* OC = (bf16_t*)(F.ws + WS_RB + RB_OC); const float* GATE = (const float*)(F.ws + WS_RS + RS_GATE); unsigned* SELM = (unsigned*)(F.ws + WS_RS + RS_SELM);
    LAS unsigned char* shm = F.lds + RING_OFF;
    const int tid = F.tid, lane = F.lane, wid = F.wave, r32 = lane & 31, hi = lane >> 5, n = wid >> 1, bg = b * 2 + g;
    const int qrel = (wid & 1) * 32 + r32, qpos = 64 * qb + qrel;
    const size_t tok = (size_t)b * SEQ + qpos;
#pragma unroll
    for (int t = 0; t < 4; ++t) {
        *(LAS u32x4*)(shm + N3_K + t * 8192 + wid * 1024 + lane * 16) = *(const u32x4*)(KC + ((size_t)bg * 256 + 64 * t + lane) * 64 + wid * 8);
        *(LAS u32x4*)(shm + N3_V + t * 8192 + wid * 1024 + lane * 16) = *(const u32x4*)(VC + ((size_t)bg * 256 + 64 * t + 16 * (wid & 3) + (lane >> 2)) * 64 + 32 * (wid >> 2) + 8 * (lane & 3));
    }
    LAS float* IMP = (LAS float*)(shm + N3_IMP); LAS float* CARRY = (LAS float*)(shm + N3_CARRY); LAS float* PH = (LAS float*)(shm + N3_PH);
    for (int i = tid; i < 4096; i += NWAVES * 64) IMP[i] = 0.f;
    if (tid < 128) CARRY[tid] = 0.f;
    ga::bf16x8 qr[4];
    { const bf16_t* qp = NQ + tok * 512 + (4 * g + n) * 64;
#pragma unroll
      for (int d0 = 0; d0 < 4; ++d0) qr[d0] = *(const ga::bf16x8*)(qp + d0 * 16 + hi * 8); }
    __syncthreads();
    const int cmax = (qpos - 31) >> 4;
    float m = ga::NEG_INF, l = 0.f;
#pragma unroll 1
    for (int t = 0; t < 4; ++t) {
        f32x16 p0, p1; ga::qkt(p0, p1, shm + N3_K + t * 8192, qr, r32, hi);
        ga::mask_gt(p0, p1, cmax - 64 * t, hi);
        float mx = fmaxf(p0[0], p1[0]);
#pragma unroll
        for (int r = 1; r < 16; ++r) mx = fmaxf(mx, fmaxf(p0[r], p1[r]));
        mx = ga::xmax(mx);
        const float mnew = fmaxf(m, mx), msafe = (mnew == ga::NEG_INF) ? 0.f : mnew;
        float rs = 0.f;
#pragma unroll
        for (int r = 0; r < 16; ++r) rs += __builtin_amdgcn_exp2f(p0[r] - msafe) + __builtin_amdgcn_exp2f(p1[r] - msafe);
        l = l * __builtin_amdgcn_exp2f(m - msafe) + rs; m = mnew;
    }
    const float lt = ga::xsum(l), inv = lt > 0.f ? 1.f / lt : 0.f, msafe = (m == ga::NEG_INF) ? 0.f : m;
    f32x16 oT[2];
#pragma unroll
    for (int i = 0; i < 2; ++i)
#pragma unroll
        for (int r = 0; r < 16; ++r) oT[i][r] = 0.f;
    const LAS unsigned char* vb0 = shm + N3_V + ((lane >> 4) & 1) * 32 + (lane & 3) * 8 + (4 * hi + ((lane & 15) >> 2)) * 64;
#pragma unroll 1
    for (int t = 0; t < 4; ++t) {
        f32x16 p0, p1; ga::qkt(p0, p1, shm + N3_K + t * 8192, qr, r32, hi);
        ga::mask_gt(p0, p1, cmax - 64 * t, hi);
#pragma unroll
        for (int r = 0; r < 16; ++r) { p0[r] = __builtin_amdgcn_exp2f(p0[r] - msafe) * inv; p1[r] = __builtin_amdgcn_exp2f(p1[r] - msafe) * inv; }
        LAS float* ph = PH + ((size_t)(n * 64 + qrel)) * 64 + 4 * hi;
#pragma unroll
        for (int g4 = 0; g4 < 4; ++g4) { *(LAS f32x4*)(ph + 8 * g4) = (f32x4){p0[4 * g4], p0[4 * g4 + 1], p0[4 * g4 + 2], p0[4 * g4 + 3]};
                                         *(LAS f32x4*)(ph + 32 + 8 * g4) = (f32x4){p1[4 * g4], p1[4 * g4 + 1], p1[4 * g4 + 2], p1[4 * g4 + 3]}; }
        ga::bf16x8 pa[4]; ga::pack_p(pa, p0, p1);
        ga::pvT<2>(oT, vb0 + t * 8192, pa);
        __syncthreads();
        {
            const int q = tid >> 3, part = tid & 7;
            const LAS float* h0 = PH + (size_t)q * 64;
            float prev;
            if (part == 0) prev = CARRY[((t & 1) ^ 1) * 64 + q];
            else { const int kv = 8 * part - 1; prev = ((h0[kv] + h0[4096 + kv]) + h0[8192 + kv]) + h0[12288 + kv]; }
#pragma unroll
            for (int k = 0; k < 2; ++k) { const int sl = 2 * part + k;
                const f32x4 a = *(const LAS f32x4*)(h0 + 4 * sl), bq = *(const LAS f32x4*)(h0 + 4096 + 4 * sl), c = *(const LAS f32x4*)(h0 + 8192 + 4 * sl), d = *(const LAS f32x4*)(h0 + 12288 + 4 * sl);
                const f32x4 ps = ((a + bq) + c) + d;
                IMP[q * 64 + 16 * t + sl] = ((ps[0] + ps[1]) + ps[2]) + 0.5f * ps[3] + 0.5f * prev;
                prev = ps[3]; }
            if (part == 7) CARRY[(t & 1) * 64 + q] = prev;
        }
        __syncthreads();
    }
    {
        const int q = tid >> 3, part = tid & 7, cur = qb;
        unsigned lo = 0u, hiw = 0u;
        if (cur < 16) { if (part == 0) lo = (2u << cur) - 1u; }
        else {
            const int nfree = 13;
            unsigned bits = 0u;
#pragma unroll 1
            for (int k = 0; k < 8; ++k) { const int s = 8 * part + k;
                if (s > cur) break;
                if (s == 0 || s >= cur - 1) { bits |= 1u << k; continue; }
                const float v = IMP[q * 64 + s]; int rank = 0;
                for (int s2 = 1; s2 < cur - 1; ++s2) { const float v2 = IMP[q * 64 + s2]; rank += (v2 > v || (v2 == v && s2 < s)) ? 1 : 0; }
                if (rank < nfree) bits |= 1u << k; }
            if (part < 4) lo = bits << (8 * part); else hiw = bits << (8 * (part - 4));
        }
        lo |= __shfl_xor(lo, 1); lo |= __shfl_xor(lo, 2); lo |= __shfl_xor(lo, 4);
        hiw |= __shfl_xor(hiw, 1); hiw |= __shfl_xor(hiw, 2); hiw |= __shfl_xor(hiw, 4);
        if (part == 0) { unsigned* sp = SELM + ((size_t)bg * SEQ + 64 * qb + q) * 2; sp[0] = lo; sp[1] = hiw; }
    }
    const float g0 = GATE[tok * 24 + (4 * g + n) * 3 + 0];
#pragma unroll
    for (int i = 0; i < 2; ++i)
#pragma unroll
        for (int r = 0; r < 16; ++r) oT[i][r] *= g0;
    bf16_t* ob = OC + ((size_t)b * SEQ + 64 * qb + (wid & 1) * 32) * 512 + (4 * g + n) * 64;
    ga::store_group(oT[0], oT[1], shm + N3_PH + wid * ga::OST_WAVE, lane, [ob](int row) { return ob + (size_t)row * 512; });
    __syncthreads();
}
}
constexpr int PH_PER_LAYER = 16, NPH = 1 + PH_PER_LAYER * DEPTH;
struct Args { Inputs in; float* out; unsigned char* ws; int ph_lo, ph_hi; };
typedef const __attribute__((address_space(4))) Args* KArgs;
typedef const __attribute__((address_space(4))) Inputs* KInputs;

__global__ void __launch_bounds__(NWAVES * 64, 2) mk_fwd(Args args) {
    extern __shared__ __attribute__((aligned(16))) unsigned char lds[];
    Frame F;
    F.lds = (LAS unsigned char*)lds;
    F.tid = threadIdx.x; F.lane = F.tid & 63; F.wave = __builtin_amdgcn_readfirstlane(F.tid >> 6);
    F.G = gridDim.x; { const int bx = blockIdx.x; F.vcu = (F.G % 8 == 0) ? (bx % 8) * (F.G / 8) + bx / 8 : bx; }
    F.ws = args.ws;
    for (int u = F.tid; u < RING_OFF / 4; u += NWAVES * 64) ((LAS unsigned*)(F.lds + MISC_OFF))[u] = 0u;
    __syncthreads();
    XcdBarrier bar; bar.bar = (unsigned*)(args.ws + WS_CTL) + CW_BAR; bar.x = 0; bar.st = nullptr;
#if !MK_PER_PHASE
    bar = xcd_barrier_post((unsigned*)(args.ws + WS_CTL) + CW_BAR, (volatile LAS unsigned*)(F.lds + MISC_OFF) + 8);
#endif
    const int lo = args.ph_lo, hi = args.ph_hi;
#ifdef MK_ONLY
#define PH_SEL(id) ((id) == MK_ONLY)
#else
#define PH_SEL(id) true
#endif
#define PH_BEGIN(idx, id) if (PH_SEL(id) && lo <= (idx) && (idx) < hi && (idx) < MK_STOP_PHASE) { \
    KArgs kp = (KArgs)__builtin_amdgcn_kernarg_segment_ptr(); asm volatile("" : "+s"(kp)); \
    const KInputs I = &kp->in; float* const out = kp->out; unsigned char* const ws = kp->ws; F.ws = ws; \
    F.tid = opaque_tid(); F.lane = F.tid & 63; F.wave = __builtin_amdgcn_readfirstlane(F.tid >> 6); \
    bf16* const XN = (bf16*)(ws + WS_XN); unsigned char* const wb = ws + WS_WB; (void)I; (void)out; (void)XN; (void)wb;
#define PH_END(idx) if ((idx) + 1 < hi) xcd_barrier(bar); }

    LAS unsigned char* const ring = F.lds + RING_OFF;
    const int bx = (int)blockIdx.x;

    PH_BEGIN(0, 0)
        rope_tables(F, I->positions);
        conv_layer(F, I, 0);
        { const int NGW = NGW_OF(F), gw = GW_OF(F);
          for (int m = gw; m < MTOK; m += NGW) norm_row_to_bf16(I->x + (size_t)m * DM, I->sandwich_g, XN + (size_t)m * DM, F.lane); }
    PH_END(0)

#pragma unroll 1
    for (int layer = 0; layer < DEPTH; ++layer) {
        const int pb = 1 + PH_PER_LAYER * layer, e = layer >> 1;

        if ((layer & 1) == 0) {
            PH_BEGIN(pb + 0, 1)
                pg8::Gemm g{XN, (const bf16*)(wb + WB_IN), MTOK, 3072, DM}; pg8::StaticOrder S; S.init(MTOK, 3072, F.G, bx);
                pg8::EpiEvenIn E{ws};
                pg8::gemm_phase<pg8::EpiEvenIn, pg8::StaticOrder, true, true>(ring, g, S, E);
            PH_END(pb + 0)
            PH_BEGIN(pb + 1, 2)
                { pg8::Gemm g{(const bf16*)(ws + WS_RA + RA_KCR), (const bf16*)(wb + WB_CMP), 4096, 512, 1024}; pg8::CmpOrder S{F.G, bx};
                  pg8::EpiF32 E{(float*)(ws + WS_RS + RS_U), 512};
                  pg8::gemm_phase<pg8::EpiF32, pg8::CmpOrder, false, true>(ring, g, S, E); }
                __syncthreads();
                for (int s = bx - 16; s < 32; s += F.G) if (s >= 0) fox_scan_seq(F, s, I->ev_fbias + e * 8);
            PH_END(pb + 1)
            PH_BEGIN(pb + 2, 3)
                compress_tail(F, I->ev_w2_k + (size_t)e * 128 * 64, I->ev_w2_v + (size_t)e * 128 * 64);
                __syncthreads();
                for (int pi = bx; pi < 256; pi += F.G) { const int bh = pi >> 3, s = pi & 7; ap::fox_unit(F, bh >> 3, bh & 7, 15 - s); ap::fox_unit(F, bh >> 3, bh & 7, s); }
            PH_END(pb + 2)
            PH_BEGIN(pb + 3, 4)
                for (int u = bx; u < 512; u += F.G) { const int bg = u >> 6, qb = u & 63; ap::nsa_cmp_unit(F, bg >> 1, bg & 1, qb); }
            PH_END(pb + 3)
            PH_BEGIN(pb + 4, 5)
                for (int pi = bx; pi < 256; pi += F.G) { const int bg = pi >> 5, s = pi & 31; ap::nsa_main_unit(F, bg >> 1, bg & 1, 63 - s); ap::nsa_main_unit(F, bg >> 1, bg & 1, s); }
            PH_END(pb + 4)
        } else {
            PH_BEGIN(pb + 0, 6)
                pg8::Gemm g{XN, (const bf16*)(wb + WB_IN), MTOK, 3072, DM}; pg8::StaticOrder S; S.init(MTOK, 3072, F.G, bx);
                pg8::EpiOddIn E{ws};
                pg8::gemm_phase<pg8::EpiOddIn, pg8::StaticOrder, true, true>(ring, g, S, E);
            PH_END(pb + 0)
            PH_BEGIN(pb + 1, 7)
                for (int pi = bx; pi < 512; pi += F.G) { const int bhv = pi >> 3, s = pi & 7; ap::diff_unit(F, bhv >> 4, bhv & 15, 15 - s); ap::diff_unit(F, bhv >> 4, bhv & 15, s); }
            PH_END(pb + 1)
            PH_BEGIN(pb + 2, 8)
                diff_combine(F, I->od_lambda + (size_t)e * 256, I->od_subln_g + (size_t)e * 128, layer);
            PH_END(pb + 2)
        }
        PH_BEGIN(pb + 5, 9)
            pg8::Gemm g{(const bf16*)(ws + WS_RB + RB_O), (const bf16*)(wb + WB_OUT), MTOK, DM, DM}; pg8::StaticOrder S; S.init(MTOK, DM, F.G, bx);
            pg8::EpiF32 E{(float*)(ws + WS_RA), DM};
            pg8::gemm_phase<pg8::EpiF32, pg8::StaticOrder, false, true>(ring, g, S, E);
        PH_END(pb + 5)
        PH_BEGIN(pb + 6, 10)
            resid_norm_rows(F, layer == 0 ? I->x : out, (const float*)(ws + WS_RA), I->sandwich_g + (size_t)layer * 6 * DM + 1 * DM, I->sandwich_g + (size_t)layer * 6 * DM + 2 * DM, out, XN);
            { const int NGW = NGW_OF(F), gw = GW_OF(F);
              for (int r = gw; r < NB * MEMT; r += NGW) norm_row_to_bf16(I->mem + (size_t)r * DM, I->mem_norm_g + (size_t)layer * DM, XN + (size_t)(MTOK + r) * DM, F.lane); }
        PH_END(pb + 6)
        PH_BEGIN(pb + 7, 11)
            pg8::Gemm g{XN, (const bf16*)(wb + WB_CQKV), MTOK + NB * MEMT, 768, DM}; pg8::CrossOrder S{F.G, bx};
            pg8::EpiCross E{(bf16*)(ws + WS_RB + RB_CQ), (bf16*)(ws + WS_RS + RS_MEMKV)};
            pg8::gemm_phase<pg8::EpiCross, pg8::CrossOrder, false, true>(ring, g, S, E);
        PH_END(pb + 7)
        PH_BEGIN(pb + 8, 12)
            for (int u = bx; u < 256; u += F.G) ap::cross_unit(F, u >> 6, (u >> 4) & 3, u & 15);
        PH_END(pb + 8)
        PH_BEGIN(pb + 9, 13)
            pg8::Gemm g{(const bf16*)(ws + WS_RB + RB_CO), (const bf16*)(wb + WB_CO), MTOK, DM, 256}; pg8::StaticOrder S; S.init(MTOK, DM, F.G, bx);
            pg8::EpiF32 E{(float*)(ws + WS_RA), DM};
            pg8::gemm_phase<pg8::EpiF32, pg8::StaticOrder, false, true>(ring, g, S, E);
        PH_END(pb + 9)
        PH_BEGIN(pb + 10, 14)
            resid_norm_rows(F, out, (const float*)(ws + WS_RA), I->sandwich_g + (size_t)layer * 6 * DM + 3 * DM, I->sandwich_g + (size_t)layer * 6 * DM + 4 * DM, out, XN);
        PH_END(pb + 10)
        PH_BEGIN(pb + 11, 15)
            pg8::Gemm g{XN, (const bf16*)(wb + WB_GU), MTOK, 2 * FFD, DM}; pg8::StaticOrder S; S.init(MTOK, 2 * FFD, F.G, bx);
            pg8::EpiSwiGLU E{(bf16*)(ws + WS_RA), FFD};
            pg8::gemm_phase<pg8::EpiSwiGLU, pg8::StaticOrder, true, true>(ring, g, S, E);
        PH_END(pb + 11)
        PH_BEGIN(pb + 12, 16)
            pg8::Gemm g{(const bf16*)(ws + WS_RA), (const bf16*)(wb + WB_D), MTOK, DM, FFD}; pg8::StaticOrder S; S.init(MTOK, DM, F.G, bx);
            pg8::EpiF32 E{(float*)(ws + WS_RB), DM};
            pg8::gemm_phase<pg8::EpiF32, pg8::StaticOrder, false, true>(ring, g, S, E);
        PH_END(pb + 12)
        PH_BEGIN(pb + 13, 17)
            resid_norm_rows(F, out, (const float*)(ws + WS_RB), I->sandwich_g + (size_t)layer * 6 * DM + 5 * DM, (layer + 1 < DEPTH) ? I->sandwich_g + (size_t)layer * 6 * DM + 6 * DM : nullptr, out, XN);
            if (layer + 1 < DEPTH) conv_layer(F, I, layer + 1);
        PH_END(pb + 13)
    }
#undef PH_BEGIN
#undef PH_END
}

extern "C" void kernel_launch(void* const* d_in, const int* in_sizes, int n_in, void* d_out, int out_size, void* d_ws, size_t ws_size, hipStream_t stream) {
    static int grid = 0;
    if (grid == 0) {
        if (n_in != 25 || in_sizes[0] != MTOK * DM || out_size != MTOK * DM || ws_size < WS_END) {
            fprintf(stderr, "kernel_launch: unexpected shapes (n_in %d, in0 %d, out %d, ws %zu < %zu); nothing launched\n", n_in, n_in > 0 ? in_sizes[0] : -1, out_size, ws_size, (size_t)WS_END); grid = -1; return; }
        int dev = 0, cus = 0, per_cu = 0;
        if (hipGetDevice(&dev) != hipSuccess || hipDeviceGetAttribute(&cus, hipDeviceAttributeMultiprocessorCount, dev) != hipSuccess) { grid = -1; return; }
        if (hipFuncSetAttribute((const void*)mk_fwd, hipFuncAttributeMaxDynamicSharedMemorySize, LDS_BYTES) != hipSuccess) { fprintf(stderr, "kernel_launch: hipFuncSetAttribute failed\n"); grid = -1; return; }
        if (hipOccupancyMaxActiveBlocksPerMultiprocessor(&per_cu, (const void*)mk_fwd, NWAVES * 64, LDS_BYTES) != hipSuccess || per_cu < 1)
            fprintf(stderr, "kernel_launch: note: occupancy query reports %d workgroups per CU\n", per_cu);
        (void)hipGetLastError();
        grid = cus;
    }
    if (grid < 0) return;
    if (hipMemsetAsync((char*)d_ws + WS_CTL, 0, CTL_ZERO_BYTES, stream) != hipSuccess) return;
    Args a{};
    const void** ip = (const void**)&a.in;
    for (int i = 0; i < 25; ++i) ip[i] = d_in[i];
    a.out = (float*)d_out; a.ws = (unsigned char*)d_ws;
#if MK_PER_PHASE
    for (int ph = 0; ph < NPH && ph < MK_STOP_PHASE; ++ph) {
        if (ph > 0) { const int l = (ph - 1) / PH_PER_LAYER, s = (ph - 1) % PH_PER_LAYER; if (s > 13) continue; if ((l & 1) && (s == 3 || s == 4)) continue; }
        a.ph_lo = ph; a.ph_hi = ph + 1;
        hipLaunchKernelGGL(mk_fwd, dim3(grid), dim3(NWAVES * 64), LDS_BYTES, stream, a);
    }
#else
    a.ph_lo = 0; a.ph_hi = NPH;
    hipLaunchKernelGGL(mk_fwd, dim3(grid), dim3(NWAVES * 64), LDS_BYTES, stream, a);
#endif
}
```
